# Optimizing an MI355X kernel written in HIP

```python
import jax, jax.numpy as jnp
from jax import lax
import numpy as np

D_MODEL = 1024
BATCH = 8
SEQ = 2048
DEPTH = 4
DEC_BATCH = 128
DEC_SEQ = 4
PAST_LEN = 2048
PAGE_SIZE = 128

N_A_LAYERS = DEPTH // 2
N_B_LAYERS = DEPTH - N_A_LAYERS
D_FF = -(-8 * D_MODEL // (3 * 256)) * 256
CHUNK = 128
D_A = 2 * D_MODEL
A_GROUPS = 8
HEAD_DIM = 64
N_HEADS = D_MODEL // HEAD_DIM
N_KV_HEADS = 4
Q_PER_KV = N_HEADS // N_KV_HEADS
ROPE_DIM = HEAD_DIM // 4
ROPE_THETA = 500000.0
CMP_STRIDE = 16
CMP_LEN = 2 * CMP_STRIDE
SEL_BLOCK = 64
SEL_TOPK = 16
WINDOW = 512
Q_BLOCK = 128
N_BRANCH = 3
EPS = 1e-6
ATTN_SCALE = HEAD_DIM ** -0.5

kernel_name = 'yoco_gmlp_nsa_decode_step'


def rmsnorm(x, g):
    xf = x.astype(jnp.float32)
    y = xf * lax.rsqrt(jnp.mean(xf * xf, axis=-1, keepdims=True) + EPS)
    return (y * g.astype(jnp.float32)).astype(x.dtype)


def layernorm(x, g, b):
    xf = x.astype(jnp.float32)
    xc = xf - jnp.mean(xf, axis=-1, keepdims=True)
    y = xc * lax.rsqrt(jnp.mean(xc * xc, axis=-1, keepdims=True) + EPS)
    return (y * g.astype(jnp.float32) + b.astype(jnp.float32)).astype(x.dtype)


def rope(x, pos):
    half = ROPE_DIM // 2
    inv_freq = ROPE_THETA ** (-jnp.arange(half, dtype=jnp.float32) / half)
    ang = pos.astype(jnp.float32)[:, None] * inv_freq[None, :]
    ang = ang.reshape((1, pos.shape[0]) + (1,) * (x.ndim - 3) + (half,))
    cos, sin = jnp.cos(ang), jnp.sin(ang)
    xf = x.astype(jnp.float32)
    x1, x2 = xf[..., :half], xf[..., half:ROPE_DIM]
    out = jnp.concatenate([x1 * cos - x2 * sin, x2 * cos + x1 * sin, xf[..., ROPE_DIM:]], axis=-1)
    return out.astype(x.dtype)


def masked_softmax(s, mask):
    s = jnp.where(mask, s, -jnp.inf)
    m = jnp.max(s, axis=-1, keepdims=True)
    m = jnp.where(jnp.isfinite(m), m, 0.0)
    e = jnp.where(mask, jnp.exp(s - m), 0.0)
    return e / jnp.maximum(jnp.sum(e, axis=-1, keepdims=True), 1e-30)


def swiglu(x, w_gate, w_up, w_down):
    return (jax.nn.silu(x @ w_gate) * (x @ w_up)) @ w_down


def pad_rows(x, mult):
    t = x.shape[1]
    tp = -(-t // mult) * mult
    return jnp.pad(x, ((0, 0), (0, tp - t)) + ((0, 0),) * (x.ndim - 2))


def chunk_gmlp(x, w_in, ln_g, ln_b, w_s, b_s, w_out):
    B, T, _ = x.shape
    uv = jax.nn.gelu(x @ w_in)
    u, v = uv[..., :D_A], uv[..., D_A:]
    v = layernorm(v, ln_g, ln_b)
    lc = CHUNK if T >= CHUNK else T
    nc = T // lc
    causal = jnp.tril(jnp.ones((lc, lc), dtype=bool))
    ws = jnp.where(causal[None], w_s[:, :lc, :lc], 0.0)
    vc = v.reshape(B, nc, lc, A_GROUPS, D_A // A_GROUPS)
    sv = jnp.einsum('gts,bcsgd->bctgd', ws, vc) + b_s[:, :lc].T[None, None, :, :, None]
    y = (u * sv.reshape(B, T, D_A)) @ w_out
    return y, v


def kv_project(h, pos, kv_norm, kv_w, k_norm_slc, k_norm_win):
    B, T, _ = h.shape
    kv = (rmsnorm(h, kv_norm) @ kv_w).reshape(B, T, N_BRANCH, 2, N_KV_HEADS, HEAD_DIM)
    kv_cmp = kv[:, :, 0]
    k_slc = rope(rmsnorm(kv[:, :, 1, 0], k_norm_slc), pos)
    k_win = rope(rmsnorm(kv[:, :, 2, 0], k_norm_win), pos)
    kv_slc = jnp.stack([k_slc, kv[:, :, 1, 1]], axis=2)
    kv_win = jnp.stack([k_win, kv[:, :, 2, 1]], axis=2)
    return kv_cmp, kv_slc, kv_win


def compress(rows, pos_k, pos_v, w_k, w_v, k_norm):
    B, T = rows.shape[:2]
    sub = rows.reshape((B, T // CMP_STRIDE, CMP_STRIDE) + rows.shape[2:])
    blk = jnp.concatenate([sub[:, :-1], sub[:, 1:]], axis=2)
    kc = jnp.einsum('bnlgd,lde->bnge', blk[:, :, :, 0] + pos_k[:, None, :], w_k)
    vc = jnp.einsum('bnlgd,lde->bnge', blk[:, :, :, 1] + pos_v[:, None, :], w_v)
    return rmsnorm(kc, k_norm), vc


def cmp_branch(q_n, q_pos, kc, vc):
    n_cmp = kc.shape[1]
    blk_end = jnp.arange(n_cmp) * CMP_STRIDE + CMP_LEN - 1
    mask = blk_end[None, :] <= q_pos[:, None]
    s = jnp.einsum('btgrd,bngd->btgrn', q_n, kc).astype(jnp.float32) * ATTN_SCALE
    p = masked_softmax(s, mask[None, :, None, None, :])
    o = jnp.einsum('btgrn,bngd->btgrd', p.astype(vc.dtype), vc)
    return o, jnp.sum(p, axis=3)


def sel_importance(imp_cmp, n_sel):
    n_cmp = imp_cmp.shape[-1]
    i = jnp.arange(n_cmp)[:, None] * CMP_STRIDE
    j = jnp.arange(n_sel)[None, :] * SEL_BLOCK
    m = ((i < j + SEL_BLOCK) & (i + CMP_LEN > j)).astype(jnp.float32)
    return imp_cmp @ m


def slc_one(q_rot, q_pos, imp_slc, kv_blocks):
    n_sel = imp_slc.shape[-1]
    blk = jnp.arange(n_sel)[None, :]
    cur = (q_pos // SEL_BLOCK)[:, None]
    valid = blk <= cur
    forced = (blk == 0) | (blk == cur) | (blk == cur - 1)
    score = jnp.where(forced[:, None], jnp.inf, jnp.where(valid[:, None], imp_slc, -jnp.inf))
    top_s, idx = lax.top_k(score, min(SEL_TOPK, n_sel))
    g_idx = jnp.arange(N_KV_HEADS)[None, :, None]
    k_g = kv_blocks[0][g_idx, idx]
    v_g = kv_blocks[1][g_idx, idx]
    key_pos = idx[..., None] * SEL_BLOCK + jnp.arange(SEL_BLOCK)
    mask = (top_s > -jnp.inf)[..., None] & (key_pos <= q_pos[:, None, None, None])
    s = jnp.einsum('tgrd,tgksd->tgrks', q_rot, k_g).astype(jnp.float32) * ATTN_SCALE
    tq, g, r, k, sb = s.shape
    p = masked_softmax(s.reshape(tq, g, r, k * sb), mask.reshape(tq, g, 1, k * sb))
    return jnp.einsum('tgrks,tgksd->tgrd', p.reshape(s.shape).astype(v_g.dtype), v_g)


def slc_branch(q_rot, q_pos, imp_slc, kv_rows):
    B, T = q_rot.shape[:2]
    qb = min(Q_BLOCK, T)
    n_qb = T // qb
    n_sel = kv_rows.shape[1] // SEL_BLOCK
    kv_blocks = kv_rows.reshape(B, n_sel, SEL_BLOCK, 2, N_KV_HEADS, HEAD_DIM).transpose(0, 3, 4, 1, 2, 5)
    xs = (q_rot.reshape(B * n_qb, qb, N_KV_HEADS, Q_PER_KV, HEAD_DIM),
          jnp.tile(q_pos.reshape(n_qb, qb), (B, 1)),
          imp_slc.reshape(B * n_qb, qb, N_KV_HEADS, n_sel),
          jnp.repeat(jnp.arange(B), n_qb))
    o = lax.map(lambda a: slc_one(a[0], a[1], a[2], kv_blocks[a[3]]), xs)
    return o.reshape(B, T, N_KV_HEADS, Q_PER_KV, HEAD_DIM)


def win_attend(q_rot, q_pos, kv, k_pos):
    kp, qp = k_pos[None, :], q_pos[:, None]
    mask = (kp <= qp) & (kp > qp - WINDOW) & (kp >= 0)
    s = jnp.einsum('btgrd,bsgd->btgrs', q_rot, kv[:, :, 0]).astype(jnp.float32) * ATTN_SCALE
    p = masked_softmax(s, mask[None, :, None, None, :])
    return jnp.einsum('btgrs,bsgd->btgrd', p.astype(kv.dtype), kv[:, :, 1])


def window_prompt(q_rot, kv_win):
    B, T = q_rot.shape[:2]
    qb = min(Q_BLOCK, T)
    n_qb = T // qb
    kv_pad = jnp.pad(kv_win, ((0, 0), (WINDOW, 0), (0, 0), (0, 0), (0, 0)))
    q_blocks = jnp.moveaxis(q_rot.reshape(B, n_qb, qb, N_KV_HEADS, Q_PER_KV, HEAD_DIM), 1, 0)

    def body(args):
        q_blk, n = args
        start = n * qb
        kv_blk = lax.dynamic_slice_in_dim(kv_pad, start, WINDOW + qb, axis=1)
        k_pos = start - WINDOW + jnp.arange(WINDOW + qb)
        return win_attend(q_blk, start + jnp.arange(qb), kv_blk, k_pos)

    o = lax.map(body, (q_blocks, jnp.arange(n_qb)))
    return jnp.moveaxis(o, 0, 1).reshape(B, T, N_KV_HEADS, Q_PER_KV, HEAD_DIM)


def nsa_mixer(xn, pos, w_in, q_norm, w_out, branches):
    B, T, _ = xn.shape
    proj = xn @ w_in
    q = proj[..., :N_HEADS * HEAD_DIM].reshape(B, T, N_KV_HEADS, Q_PER_KV, HEAD_DIM)
    gates = jax.nn.sigmoid(proj[..., N_HEADS * HEAD_DIM:].astype(jnp.float32)).reshape(B, T, N_KV_HEADS, Q_PER_KV, N_BRANCH)
    q_n = rmsnorm(q, q_norm)
    o_cmp, o_slc, o_win = branches(q_n, rope(q_n, pos))
    o = (gates[..., 0:1] * o_cmp.astype(jnp.float32) + gates[..., 1:2] * o_slc.astype(jnp.float32)
         + gates[..., 2:3] * o_win.astype(jnp.float32))
    return o.astype(xn.dtype).reshape(B, T, N_HEADS * HEAD_DIM) @ w_out


def trunk(x, pos, make_branches, norm_mix, norm_ffn, ffn_w_gate, ffn_w_up, ffn_w_down,
          a_w_in, a_ln_g, a_ln_b, a_w_spatial, a_b_spatial, a_w_out, b_w_in, b_q_norm, b_w_out):
    h = x
    a_v = []
    branches, kv_state = None, None
    for l in range(DEPTH):
        xn = rmsnorm(h, norm_mix[l])
        if l < N_A_LAYERS:
            y, v = chunk_gmlp(xn, a_w_in[l], a_ln_g[l], a_ln_b[l], a_w_spatial[l], a_b_spatial[l], a_w_out[l])
            a_v.append(v)
        else:
            if branches is None:
                branches, kv_state = make_branches(h)
            j = l - N_A_LAYERS
            y = nsa_mixer(xn, pos, b_w_in[j], b_q_norm[j], b_w_out[j], branches)
        h = h + y
        h = h + swiglu(rmsnorm(h, norm_ffn[l]), ffn_w_gate[l], ffn_w_up[l], ffn_w_down[l])
    return h, jnp.stack(a_v), kv_state


def setup_inputs(seed: int = 0) -> dict:
    key = jax.random.key(seed)
    k = jax.random.split(key, 32)
    f32 = jnp.float32

    def nrm(kk, shape, scale):
        return jax.random.normal(kk, shape, f32) * scale

    def gain(kk, shape):
        return 1.0 + 0.05 * jax.random.normal(kk, shape, f32)

    n_pages = PAST_LEN // PAGE_SIZE
    n_used = DEC_BATCH * n_pages
    n_pool = (n_used * 5) // 4
    win_buf = min(WINDOW, PAST_LEN)
    kv_row = (2, N_KV_HEADS, HEAD_DIM)
    d_in_b = N_HEADS * HEAD_DIM + N_BRANCH * N_HEADS
    page_table = jax.random.permutation(k[5], n_pool)[:n_used].reshape(DEC_BATCH, n_pages).astype(jnp.int32)
    return {
        'x_prompt': nrm(k[0], (BATCH, SEQ, D_MODEL), 1.0),
        'x_sample': nrm(k[1], (DEC_BATCH, DEC_SEQ, D_MODEL), 1.0),
        'cache_kv_cmp': nrm(k[2], (n_pool, PAGE_SIZE) + kv_row, 1.0),
        'cache_kv_slc': nrm(k[3], (n_pool, PAGE_SIZE) + kv_row, 1.0),
        'state_kv_win': nrm(k[4], (DEC_BATCH, win_buf) + kv_row, 1.0),
        'page_table': page_table,
        'norm_mix': gain(k[6], (DEPTH, D_MODEL)),
        'norm_ffn': gain(k[7], (DEPTH, D_MODEL)),
        'ffn_w_gate': nrm(k[8], (DEPTH, D_MODEL, D_FF), D_MODEL ** -0.5),
        'ffn_w_up': nrm(k[9], (DEPTH, D_MODEL, D_FF), D_MODEL ** -0.5),
        'ffn_w_down': nrm(k[10], (DEPTH, D_FF, D_MODEL), D_FF ** -0.5),
        'a_w_in': nrm(k[11], (N_A_LAYERS, D_MODEL, 2 * D_A), D_MODEL ** -0.5),
        'a_ln_g': gain(k[12], (N_A_LAYERS, D_A)),
        'a_ln_b': nrm(k[13], (N_A_LAYERS, D_A), 0.02),
        'a_w_spatial': nrm(k[14], (N_A_LAYERS, A_GROUPS, CHUNK, CHUNK), 0.5 * CHUNK ** -0.5),
        'a_b_spatial': gain(k[15], (N_A_LAYERS, A_GROUPS, CHUNK)),
        'a_w_out': nrm(k[16], (N_A_LAYERS, D_A, D_MODEL), D_A ** -0.5),
        'kv_norm': gain(k[17], (D_MODEL,)),
        'kv_w': nrm(k[18], (D_MODEL, N_BRANCH * 2 * N_KV_HEADS * HEAD_DIM), D_MODEL ** -0.5),
        'k_norm_cmp': gain(k[19], (HEAD_DIM,)),
        'k_norm_slc': gain(k[20], (HEAD_DIM,)),
        'k_norm_win': gain(k[21], (HEAD_DIM,)),
        'cmp_pos_k': nrm(k[22], (CMP_LEN, HEAD_DIM), 0.5),
        'cmp_pos_v': nrm(k[23], (CMP_LEN, HEAD_DIM), 0.5),
        'cmp_w_k': nrm(k[24], (CMP_LEN, HEAD_DIM, HEAD_DIM), (CMP_LEN * HEAD_DIM) ** -0.5),
        'cmp_w_v': nrm(k[25], (CMP_LEN, HEAD_DIM, HEAD_DIM), (CMP_LEN * HEAD_DIM) ** -0.5),
        'b_w_in': nrm(k[26], (N_B_LAYERS, D_MODEL, d_in_b), D_MODEL ** -0.5),
        'b_q_norm': gain(k[27], (N_B_LAYERS, HEAD_DIM)),
        'b_w_out': nrm(k[28], (N_B_LAYERS, N_HEADS * HEAD_DIM, D_MODEL), (N_HEADS * HEAD_DIM) ** -0.5),
    }


def reference(x_prompt, x_sample, cache_kv_cmp, cache_kv_slc, state_kv_win, page_table,
              norm_mix, norm_ffn, ffn_w_gate, ffn_w_up, ffn_w_down,
              a_w_in, a_ln_g, a_ln_b, a_w_spatial, a_b_spatial, a_w_out,
              kv_norm, kv_w, k_norm_cmp, k_norm_slc, k_norm_win,
              cmp_pos_k, cmp_pos_v, cmp_w_k, cmp_w_v,
              b_w_in, b_q_norm, b_w_out):
    layer_w = (norm_mix, norm_ffn, ffn_w_gate, ffn_w_up, ffn_w_down,
               a_w_in, a_ln_g, a_ln_b, a_w_spatial, a_b_spatial, a_w_out, b_w_in, b_q_norm, b_w_out)
    cmp_w = (cmp_pos_k, cmp_pos_v, cmp_w_k, cmp_w_v, k_norm_cmp)
    kv_wts = (kv_norm, kv_w, k_norm_slc, k_norm_win)

    t_p = x_prompt.shape[1]
    pos_p = jnp.arange(t_p)

    def prompt_branches(h):
        kv_cmp, kv_slc, kv_win = kv_project(h, pos_p, *kv_wts)
        kc, vc = compress(kv_cmp, *cmp_w)
        n_sel = t_p // SEL_BLOCK

        def branches(q_n, q_rot):
            o_cmp, imp = cmp_branch(q_n, pos_p, kc, vc)
            o_slc = slc_branch(q_rot, pos_p, sel_importance(imp, n_sel), kv_slc)
            o_win = window_prompt(q_rot, kv_win)
            return o_cmp, o_slc, o_win

        return branches, (kv_cmp, kv_slc, kv_win[:, t_p - min(WINDOW, t_p):])

    y_prompt, _, (kv_cmp_p, kv_slc_p, kv_win_p) = trunk(x_prompt, pos_p, prompt_branches, *layer_w)

    b_s, t_s = x_sample.shape[:2]
    pos_s = PAST_LEN + jnp.arange(t_s)

    def sample_branches(h):
        new_cmp, new_slc, new_win = kv_project(h, pos_s, *kv_wts)
        past_shape = (b_s, page_table.shape[1] * PAGE_SIZE) + cache_kv_cmp.shape[2:]
        full_cmp = pad_rows(jnp.concatenate([cache_kv_cmp[page_table].reshape(past_shape), new_cmp], axis=1), SEL_BLOCK)
        full_slc = pad_rows(jnp.concatenate([cache_kv_slc[page_table].reshape(past_shape), new_slc], axis=1), SEL_BLOCK)
        kc, vc = compress(full_cmp, *cmp_w)
        n_sel = full_slc.shape[1] // SEL_BLOCK
        win_buf = state_kv_win.shape[1]
        kv_win_all = jnp.concatenate([state_kv_win, new_win], axis=1)
        win_pos = PAST_LEN - win_buf + jnp.arange(win_buf + t_s)

        def branches(q_n, q_rot):
            o_cmp, imp = cmp_branch(q_n, pos_s, kc, vc)
            o_slc = slc_branch(q_rot, pos_s, sel_importance(imp, n_sel), full_slc)
            o_win = win_attend(q_rot, pos_s, kv_win_all, win_pos)
            return o_cmp, o_slc, o_win

        return branches, (new_cmp, new_slc, kv_win_all[:, t_s:])

    y_sample, a_v_sample, (kv_cmp_s, kv_slc_s, kv_win_s) = trunk(x_sample, pos_s, sample_branches, *layer_w)

    return (y_prompt, y_sample, kv_cmp_p, kv_cmp_s, kv_slc_p, kv_slc_s, kv_win_p, kv_win_s, a_v_sample)
```

```cpp
#include <hip/hip_runtime.h>
#include <cstdio>
#include <cstdint>
#include <cmath>
namespace pg8 {
#define PG8_LAS __attribute__((address_space(3)))
typedef unsigned short bf16_t;
typedef short bf16x8 __attribute__((ext_vector_type(8)));
typedef float f32x4 __attribute__((ext_vector_type(4)));
typedef unsigned u32x4 __attribute__((ext_vector_type(4)));
constexpr int BM = 256, BK = 64, HALF = 128, HTB = HALF * BK * 2  , STAGE_BYTES = 8 * HTB, NXCD = 8, WGM = 8;

__host__ __device__ __forceinline__ int lds_byte(int r, int c) { const int st = (r >> 4) * 2 + (c >> 5), rr = r & 15, cc = c & 31, ob = rr * 64 + cc * 2; return st * 1024 + (ob ^ (((ob >> 9) & 1) << 5)); }
__host__ __device__ __forceinline__ void stage_rc(int b, int& R, int& C) { const int st = b / 1024, sb = b % 1024, swz = sb ^ (((sb >> 9) & 1) << 5); R = (st >> 1) * 16 + swz / 64; C = (st & 1) * 32 + (swz % 64) / 2; }
__host__ __device__ __forceinline__ int perm32(int rho) { const int n = rho >> 4, i = rho & 15; return 8 * (i >> 2) + 4 * n + (i & 3); }

struct Unit { int pm, pn; };
struct Gemm { const bf16_t* A; const bf16_t* Bt; int M, N, K; };

struct StaticOrder {
    int nM, nN, nwg, G, c;
    __host__ __device__ void init(int M, int N, int G_, int c_) { nM = M / BM; nN = N / BM; nwg = nM * nN; G = G_; c = c_; }
    __host__ __device__ bool next(int i, Unit& u) const {
        const long L = (long)i * G + c; if (L >= nwg) return false;
        int wgid = (int)L; { const int q = nwg / NXCD, r = nwg % NXCD, xcd = wgid % NXCD, off = wgid / NXCD; wgid = (xcd < r ? xcd * (q + 1) : r * (q + 1) + (xcd - r) * q) + off; }
        const int nig = WGM * nN, gid = wgid / nig, fm = gid * WGM, gsz = (nM - fm) < WGM ? (nM - fm) : WGM;
        u.pm = fm + ((wgid % nig) % gsz); u.pn = (wgid % nig) / gsz; return true;
    }
    __device__ __forceinline__ void a_ready(const Unit&) const {}
    __device__ __forceinline__ void done(const Unit&) const {}
};

__device__ __forceinline__ unsigned cvt_pk_bf16(float lo, float hi) { unsigned r; asm volatile("v_cvt_pk_bf16_f32 %0, %1, %2" : "=v"(r) : "v"(lo), "v"(hi)); return r; }
typedef float f32x2 __attribute__((ext_vector_type(2)));
__device__ __forceinline__ f32x2 gelu_pk(f32x2 v) {
    const f32x2 av = __builtin_elementwise_abs(v), d = av * 0.2316418882f + 1.0f;
    f32x2 t; t.x = __builtin_amdgcn_rcpf(d.x); t.y = __builtin_amdgcn_rcpf(d.y);
    f32x2 q = t * 0.5307027145f + (-0.7265760135f); q = q * t + 0.7107068705f; q = q * t + (-0.142248368f); q = q * t + 0.127414796f; q = q * t;
    const f32x2 s = (v * v) * (-0.72134752044f);
    f32x2 e; e.x = __builtin_amdgcn_exp2f(s.x); e.y = __builtin_amdgcn_exp2f(s.y);
    const f32x2 m = v * (q * e), r = v - m;
    f32x2 o; o.x = v.x < 0.f ? m.x : r.x; o.y = v.y < 0.f ? m.y : r.y; return o;
}

template <int ACT  > struct EpiBf16 {
    static constexpr bool PERM = true, AFTER_DRAIN = false; static_assert(ACT == 0 || ACT == 1, "EpiBf16: ACT is 0 (none) or 1 (gelu_pk)");
    bf16_t* O; int ldc; const float* bias; int split_cols; size_t split_stride; float scale0;
    __device__ __forceinline__ void operator()(const f32x4 (&acc)[2][2][4][2], const Unit& u, int wr, int wc, int fr, int fq) const {
        const int row0 = u.pm * BM + wr * 64 + fr; int colt = u.pn * BM; bf16_t* base = O;
        float sc = 1.f; if (split_cols) { const int t = colt / split_cols; base += (size_t)t * split_stride; colt -= t * split_cols; if (t == 0) sc = scale0; }
        const int col0 = colt + wc * 32 + 8 * fq, bcol0 = u.pn * BM + wc * 32 + 8 * fq;
        f32x4 bv[2][2];
#pragma unroll
        for (int bj = 0; bj < 2; ++bj)
#pragma unroll
            for (int n = 0; n < 2; ++n) bv[bj][n] = bias ? *(const f32x4*)(bias + bcol0 + bj * HALF + 4 * n) : (f32x4){0.f, 0.f, 0.f, 0.f};
#pragma unroll
        for (int ai = 0; ai < 2; ++ai)
#pragma unroll
            for (int m = 0; m < 4; ++m) { bf16_t* rowp = base + (size_t)(row0 + ai * HALF + m * 16) * ldc + col0;
#pragma unroll
                for (int bj = 0; bj < 2; ++bj) { f32x4 v0 = acc[ai][bj][m][0] + bv[bj][0], v1 = acc[ai][bj][m][1] + bv[bj][1];
                    if (ACT == 1) { f32x2 a = gelu_pk((f32x2){v0[0], v0[1]}), b = gelu_pk((f32x2){v0[2], v0[3]}), c = gelu_pk((f32x2){v1[0], v1[1]}), d = gelu_pk((f32x2){v1[2], v1[3]});
                        v0 = (f32x4){a.x, a.y, b.x, b.y}; v1 = (f32x4){c.x, c.y, d.x, d.y}; }
                    v0 = v0 * sc; v1 = v1 * sc; u32x4 w; w.x = cvt_pk_bf16(v0[0], v0[1]); w.y = cvt_pk_bf16(v0[2], v0[3]); w.z = cvt_pk_bf16(v1[0], v1[1]); w.w = cvt_pk_bf16(v1[2], v1[3]);
                    *(u32x4*)(rowp + bj * HALF) = w; } }
    }
};
template <class Epi, class Sched, bool ALIGN_EPI = false, bool SP2 = false>
__device__ __forceinline__ void gemm_phase(PG8_LAS unsigned char* lds, const Gemm g, const Sched& S, const Epi& E) {
    const int tid = threadIdx.x, wid = __builtin_amdgcn_readfirstlane(tid >> 6), lane = tid & 63, wr = wid >> 2, wc = wid & 3, fr = lane & 15, fq = lane >> 4;
    const int K = g.K, nt = K / BK;
    unsigned voffA[2], voffB[2];
#pragma unroll
    for (int i = 0; i < 2; ++i) { int R, C; stage_rc(tid * 16 + i * 8192, R, C); const int Rb = Epi::PERM ? ((R & ~31) + perm32(R & 31)) : R;
        voffA[i] = (unsigned)(R * K + C) * 2u; voffB[i] = (unsigned)(Rb * K + C) * 2u; }
    const size_t kstep = (size_t)(BK * 2);
    const size_t hstep = (size_t)HALF * K * 2;
    const size_t tstep = 2 * hstep;
    const unsigned ldsw = (unsigned)wid * 1024u;
    const int aoff = lds_byte(wr * 64 + fr, fq * 8), boff = lds_byte(wc * 32 + fr, fq * 8);
#define PG8_SA(b, h) (((b) * 2 + (h)) * HTB)
#define PG8_SB(b, h) ((4 + (b) * 2 + (h)) * HTB)
#define PG8_STAGE(bufoff, gbase, voff) do { _Pragma("unroll") for (int _i = 0; _i < 2; ++_i) \
        __builtin_amdgcn_global_load_lds((const unsigned*)((const char*)(gbase) + (voff)[_i]), (PG8_LAS unsigned*)(lds + (bufoff) + ldsw + _i * 8192), 16, 0, 0); } while (0)
#define PG8_LDA(dst, b, h) do { _Pragma("unroll") for (int m = 0; m < 4; ++m) _Pragma("unroll") for (int k = 0; k < 2; ++k) dst[m][k] = *(const PG8_LAS bf16x8*)(lds + PG8_SA(b, h) + aoff + m * 2048 + k * 1024); } while (0)
#define PG8_LDB(dst, b, h) do { _Pragma("unroll") for (int n = 0; n < 2; ++n) _Pragma("unroll") for (int k = 0; k < 2; ++k) dst[n][k] = *(const PG8_LAS bf16x8*)(lds + PG8_SB(b, h) + boff + n * 2048 + k * 1024); } while (0)
#define PG8_MMA(ai, bj, At, Bt) do { __builtin_amdgcn_s_setprio(1); _Pragma("unroll") for (int m = 0; m < 4; ++m) _Pragma("unroll") for (int n = 0; n < 2; ++n) _Pragma("unroll") for (int k = 0; k < 2; ++k) \
        acc[ai][bj][m][n] = __builtin_amdgcn_mfma_f32_16x16x32_bf16(Bt[n][k], At[m][k], acc[ai][bj][m][n], 0, 0, 0); __builtin_amdgcn_s_setprio(0); } while (0)
#define PG8_WAIT_V(n) asm volatile("s_waitcnt vmcnt(" #n ")" ::: "memory")
#define PG8_WAIT_L(n) asm volatile("s_waitcnt lgkmcnt(" #n ")" ::: "memory")
#define PG8_BAR __builtin_amdgcn_s_barrier()
#define PG8_SCHED __builtin_amdgcn_sched_barrier(0)
    Unit cur, nxt; int ui = 0;
    if (!S.next(0, cur)) return;
    f32x4 acc[2][2][4][2];
#pragma unroll
    for (int a = 0; a < 2; ++a)
#pragma unroll
        for (int b = 0; b < 2; ++b)
#pragma unroll
            for (int m = 0; m < 4; ++m)
#pragma unroll
                for (int n = 0; n < 2; ++n) acc[a][b][m][n] = (f32x4){0.f, 0.f, 0.f, 0.f};
    bf16x8 At[4][2], B0[2][2], B1[2][2];
    const char* cA = (const char*)g.A + (size_t)cur.pm * tstep; const char* cB = (const char*)g.Bt + (size_t)cur.pn * tstep;
    S.a_ready(cur);
    if constexpr (SP2) {
        PG8_STAGE(PG8_SB(0, 0), cB, voffB); PG8_STAGE(PG8_SB(0, 1), cB + hstep, voffB); PG8_STAGE(PG8_SA(0, 0), cA, voffA); PG8_STAGE(PG8_SA(0, 1), cA + hstep, voffA);
        if (wr == 1) PG8_BAR;
        PG8_WAIT_V(2); PG8_BAR;
        PG8_STAGE(PG8_SB(1, 0), cB + kstep, voffB); PG8_STAGE(PG8_SA(1, 0), cA + kstep, voffA); PG8_STAGE(PG8_SB(1, 1), cB + hstep + kstep, voffB);
        PG8_WAIT_V(6); PG8_BAR;
    } else {
        PG8_STAGE(PG8_SB(0, 0), cB, voffB); PG8_STAGE(PG8_SA(0, 0), cA, voffA); PG8_STAGE(PG8_SB(0, 1), cB + hstep, voffB); PG8_STAGE(PG8_SA(0, 1), cA + hstep, voffA);
        if (wr == 1) PG8_BAR;
        PG8_WAIT_V(4); PG8_BAR;
        PG8_STAGE(PG8_SB(1, 0), cB + kstep, voffB); PG8_STAGE(PG8_SA(1, 0), cA + kstep, voffA); PG8_STAGE(PG8_SB(1, 1), cB + hstep + kstep, voffB);
        PG8_WAIT_V(6); PG8_BAR;
    }
    for (;;) {
        const bool has_next = S.next(ui + 1, nxt);
        const char* nA = has_next ? (const char*)g.A + (size_t)nxt.pm * tstep : cA; const char* nB = has_next ? (const char*)g.Bt + (size_t)nxt.pn * tstep : cB;
        for (int t = 0; t < nt; t += 2) {
            const bool last = (t == nt - 2);
            const char* a1 = cA + (size_t)(t + 1) * kstep;
            const char* a2 = last ? nA : cA + (size_t)(t + 2) * kstep; const char* b2 = last ? nB : cB + (size_t)(t + 2) * kstep;
            const char* a3 = a2 + kstep; const char* b3 = b2 + kstep;
            if (last && has_next) S.a_ready(nxt);
            if constexpr (SP2) {
            PG8_LDB(B0, 0, 0); PG8_LDB(B1, 0, 1); PG8_SCHED; PG8_LDA(At, 0, 0); PG8_STAGE(PG8_SA(1, 1), a1 + hstep, voffA);
            PG8_WAIT_V(8); PG8_WAIT_L(0); PG8_BAR; PG8_MMA(0, 0, At, B0); PG8_MMA(0, 1, At, B1); PG8_BAR; PG8_SCHED;
            PG8_LDA(At, 0, 1); PG8_STAGE(PG8_SB(0, 0), b2, voffB); PG8_STAGE(PG8_SB(0, 1), b2 + hstep, voffB); PG8_STAGE(PG8_SA(0, 0), a2, voffA);
            PG8_WAIT_V(8); PG8_WAIT_L(0); PG8_BAR; PG8_MMA(1, 0, At, B0); PG8_MMA(1, 1, At, B1); PG8_BAR; PG8_SCHED;
            PG8_LDB(B0, 1, 0); PG8_LDB(B1, 1, 1); PG8_SCHED; PG8_LDA(At, 1, 0); PG8_STAGE(PG8_SA(0, 1), a2 + hstep, voffA);
            PG8_WAIT_V(8); PG8_WAIT_L(0); PG8_BAR; PG8_MMA(0, 0, At, B0); PG8_MMA(0, 1, At, B1); PG8_BAR; PG8_SCHED;
            PG8_LDA(At, 1, 1); PG8_STAGE(PG8_SB(1, 0), b3, voffB); PG8_STAGE(PG8_SB(1, 1), b3 + hstep, voffB); PG8_STAGE(PG8_SA(1, 0), a3, voffA);
            PG8_WAIT_V(8); PG8_WAIT_L(0); PG8_BAR; PG8_MMA(1, 0, At, B0); PG8_MMA(1, 1, At, B1); PG8_BAR; PG8_SCHED;
            } else {
            PG8_LDB(B0, 0, 0); PG8_SCHED; PG8_LDA(At, 0, 0); PG8_STAGE(PG8_SA(1, 1), a1 + hstep, voffA);
            PG8_WAIT_L(8); PG8_BAR; PG8_WAIT_L(0); PG8_MMA(0, 0, At, B0); PG8_BAR; PG8_SCHED;
            PG8_LDB(B1, 0, 1); PG8_STAGE(PG8_SB(0, 0), b2, voffB);
            PG8_BAR; PG8_WAIT_L(0); PG8_MMA(0, 1, At, B1); PG8_BAR;
            PG8_LDA(At, 0, 1); PG8_STAGE(PG8_SA(0, 0), a2, voffA);
            PG8_BAR; PG8_WAIT_L(0); PG8_MMA(1, 0, At, B0); PG8_BAR; PG8_SCHED;
            PG8_STAGE(PG8_SB(0, 1), b2 + hstep, voffB);
            PG8_WAIT_V(6); PG8_BAR; PG8_MMA(1, 1, At, B1); PG8_BAR;
            PG8_LDB(B0, 1, 0); PG8_SCHED; PG8_LDA(At, 1, 0); PG8_STAGE(PG8_SA(0, 1), a2 + hstep, voffA);
            PG8_WAIT_L(8); PG8_BAR; PG8_WAIT_L(0); PG8_MMA(0, 0, At, B0); PG8_BAR; PG8_SCHED;
            PG8_LDB(B1, 1, 1); PG8_STAGE(PG8_SB(1, 0), b3, voffB);
            PG8_BAR; PG8_WAIT_L(0); PG8_MMA(0, 1, At, B1); PG8_BAR;
            PG8_LDA(At, 1, 1); PG8_STAGE(PG8_SA(1, 0), a3, voffA);
            PG8_BAR; PG8_WAIT_L(0); PG8_MMA(1, 0, At, B0); PG8_BAR; PG8_SCHED;
            PG8_STAGE(PG8_SB(1, 1), b3 + hstep, voffB);
            PG8_WAIT_V(6); PG8_BAR; PG8_MMA(1, 1, At, B1); PG8_BAR;
            }
        }
        if constexpr (ALIGN_EPI) { if (wr == 0) PG8_BAR; }
        if constexpr (!Epi::AFTER_DRAIN) { E(acc, cur, wr, wc, fr, fq); S.done(cur); }
        if (!has_next) break;
#pragma unroll
        for (int a = 0; a < 2; ++a)
#pragma unroll
            for (int b = 0; b < 2; ++b)
#pragma unroll
                for (int m = 0; m < 4; ++m)
#pragma unroll
                    for (int n = 0; n < 2; ++n) acc[a][b][m][n] = (f32x4){0.f, 0.f, 0.f, 0.f};
        cur = nxt; cA = nA; cB = nB; ++ui;
        if constexpr (ALIGN_EPI) { if (wr == 1) PG8_BAR; }
    }
    PG8_WAIT_V(0);
    if constexpr (!ALIGN_EPI) { if (wr == 0) PG8_BAR; }
    PG8_BAR;
    if constexpr (Epi::AFTER_DRAIN) { E.fused(acc, cur, wr, wc, fr, fq, lds, wid, lane); S.done(cur); }
#undef PG8_SA
#undef PG8_SB
#undef PG8_STAGE
#undef PG8_LDA
#undef PG8_LDB
#undef PG8_MMA
#undef PG8_WAIT_V
#undef PG8_WAIT_L
#undef PG8_BAR
#undef PG8_SCHED
}
}
#define GAS __attribute__((address_space(1)))
#define LAS __attribute__((address_space(3)))
typedef unsigned short bf16;
typedef unsigned v4u __attribute__((ext_vector_type(4)));
typedef float f32x4 __attribute__((ext_vector_type(4)));
typedef short bf16x8 __attribute__((ext_vector_type(8)));
typedef GAS unsigned gu32;
typedef GAS unsigned long long gu64;
#define RLX_AGENT __ATOMIC_RELAXED, __HIP_MEMORY_SCOPE_AGENT
#define LDS_WAIT() asm volatile("s_waitcnt lgkmcnt(0)" ::: "memory")
#define VM_WAIT() asm volatile("s_waitcnt vmcnt(0)" ::: "memory")
__device__ __forceinline__ unsigned long long rt() { return __builtin_amdgcn_s_memrealtime(); }
__device__ __forceinline__ unsigned f2bf(float f) { unsigned u = __builtin_bit_cast(unsigned, f); return (u + 0x7fffu + ((u >> 16) & 1u)) >> 16; }
__device__ __forceinline__ unsigned pk2(float lo, float hi) { return f2bf(lo) | (f2bf(hi) << 16); }
#define XB_TMO      128
#define XB_XCNT(j)  (256  + 64 * (j))
#define XB_XSUB(j)  (1280 + 64 * (j))
#define XB_XGEN(j)  (2304 + 64 * (j))
#define XB_TOP      3328
#define XB_TOPGEN   3392
#define XCD_BAR_WORDS 3456
#define XB_SPIN_CAP (1u << 18)

__device__ __forceinline__ unsigned xb_ld(unsigned* p)              { return __hip_atomic_load(p, __ATOMIC_RELAXED, __HIP_MEMORY_SCOPE_AGENT); }
__device__ __forceinline__ unsigned xb_add(unsigned* p, unsigned v) { return __hip_atomic_fetch_add(p, v, __ATOMIC_RELAXED, __HIP_MEMORY_SCOPE_AGENT); }
__device__ __forceinline__ unsigned xb_xcc_id() { return (unsigned)__builtin_amdgcn_s_getreg((3 << 11) | 20) & 0xFu; }
#define XB_SPIN(cond, bar) do { unsigned _sp = 0; while (cond) { __builtin_amdgcn_s_sleep(1); \
    if ((++_sp & 255u) == 0u) { if (xb_ld(&(bar)[XB_TMO])) break; if (_sp > XB_SPIN_CAP) { atomicAdd(&(bar)[XB_TMO], 1u); break; } } } } while (0)

struct XcdBarrier {
    unsigned* bar; unsigned x;
    volatile LAS unsigned* st;
};

__device__ __forceinline__ XcdBarrier xcd_barrier_post(unsigned* bar, volatile LAS unsigned* st) {
    XcdBarrier b; b.bar = bar; b.x = xb_xcc_id(); b.st = st;
    if (threadIdx.x == 0) (void)xb_add(&bar[XB_XCNT(b.x)], 1u);
    return b;
}
__device__ __forceinline__ void xcd_barrier_complete(unsigned* bar, unsigned x, unsigned& nloc, unsigned& nx) {
    const unsigned G = gridDim.x * gridDim.y * gridDim.z;
    unsigned sum, cnt, mine, sp = 0u;
    for (;;) {
        sum = 0u; cnt = 0u; mine = 0u;
#pragma unroll
        for (unsigned j = 0; j < 16; ++j) { const unsigned c = xb_ld(&bar[XB_XCNT(j)]); sum += c; cnt += (c > 0u) ? 1u : 0u; mine = (j == x) ? c : mine; }
        if (sum == G) break;
        __builtin_amdgcn_s_sleep(1);
        if ((++sp & 255u) == 0u) { if (xb_ld(&bar[XB_TMO])) break; if (sp > XB_SPIN_CAP) { atomicAdd(&bar[XB_TMO], 1u); break; } }
    }
    nloc = mine > 0u ? mine : 1u; nx = cnt > 0u ? cnt : 1u;
}

__device__ __forceinline__ void xcd_barrier(const XcdBarrier& b) {
    asm volatile("s_waitcnt vmcnt(0)" ::: "memory");
    __syncthreads();
    if (threadIdx.x == 0) {
        unsigned* bar = b.bar;
        __builtin_amdgcn_s_waitcnt(0);
        unsigned nloc = b.st[0], nx = b.st[1];
        if (nloc == 0u) { xcd_barrier_complete(bar, b.x, nloc, nx); b.st[0] = nloc; b.st[1] = nx; }
        const unsigned old = xb_add(&bar[XB_XSUB(b.x)], 1u);
        const unsigned gen = old / nloc;
        if (old + 1u == (gen + 1u) * nloc) {
            __builtin_amdgcn_fence(__ATOMIC_RELEASE, "agent");
            asm volatile("s_waitcnt vmcnt(0)" ::: "memory");
            const unsigned og = xb_add(&bar[XB_TOP], 1u);
            const unsigned tg = og / nx;
            if (og + 1u == (tg + 1u) * nx) xb_add(&bar[XB_TOPGEN], 1u);
            else XB_SPIN(xb_ld(&bar[XB_TOPGEN]) == tg, bar);
            __builtin_amdgcn_fence(__ATOMIC_ACQUIRE, "agent");
            xb_add(&bar[XB_XGEN(b.x)], 1u);
            asm volatile("s_waitcnt vmcnt(0)" ::: "memory");
        } else {
            XB_SPIN(xb_ld(&bar[XB_XGEN(b.x)]) == gen, bar);
            __builtin_amdgcn_fence(__ATOMIC_ACQUIRE, "agent");
            asm volatile("s_waitcnt vmcnt(0)" ::: "memory");
        }
    }
    __syncthreads();
}

constexpr int NWAVES = 8, NTHR = 512;
constexpr int MP = 16384, MS = 512, M = MP + MS;
constexpr int DM = 1024, DFF = 2816, DA = 2048, SEQ = 2048;
constexpr int NKVQ = 2816, NQ3 = 1280;
constexpr float EPS = 1e-6f;
constexpr size_t MiB = 1u << 20;

enum { I_XP = 0, I_XS, I_CCMP, I_CSLC, I_SWIN, I_PT, I_NMIX, I_NFFN, I_WG, I_WU, I_WD, I_AWIN, I_ALNG, I_ALNB, I_AWS, I_ABS, I_AWOUT,
       I_KVN, I_KVW, I_KNC, I_KNS, I_KNW, I_CPK, I_CPV, I_CWK, I_CWV, I_BWIN, I_BQN, I_BWOUT, N_IN };

constexpr size_t O_Y = 0;
constexpr size_t O_KVCMP = (size_t)M * DM;
constexpr size_t O_KVSLC = O_KVCMP + (size_t)M * 512;
constexpr size_t O_WINP = O_KVSLC + (size_t)M * 512;
constexpr size_t O_WINS = O_WINP + (size_t)8 * 512 * 512;
constexpr size_t O_AV = O_WINS + (size_t)128 * 512 * 512;
constexpr size_t O_END = O_AV + (size_t)2 * 128 * 4 * 2048;

constexpr size_t WS_CTL = 0, CTL_ZERO_BYTES = 1 * MiB;
constexpr size_t WS_WIN = 2 * MiB;
constexpr size_t WS_WOUTA = 18 * MiB;
constexpr size_t WS_WGU = 26 * MiB;
constexpr size_t WS_WD = 70 * MiB;
constexpr size_t WS_WKVQ = 92 * MiB;
constexpr size_t WS_WQ3 = 98 * MiB;
constexpr size_t WS_WOB = 101 * MiB;
constexpr size_t WS_XN = 112 * MiB;
constexpr size_t WS_UV = 146 * MiB;
constexpr size_t WS_GATED = 278 * MiB;
constexpr size_t WS_ACT = 344 * MiB;
constexpr size_t WS_PROJ = 435 * MiB;
constexpr size_t WS_O = 617 * MiB;
constexpr size_t WS_QN = 650 * MiB;
constexpr size_t WS_QR = 716 * MiB;
constexpr size_t WS_GATES = 782 * MiB;
constexpr size_t WS_KVWIN = 786 * MiB;
constexpr size_t WS_OC = 819 * MiB;
constexpr size_t WS_OS = 885 * MiB;
constexpr size_t WS_PCMP = 951 * MiB;
constexpr size_t WS_SCORE = 1083 * MiB;
constexpr size_t WS_SELM = 1094 * MiB;
constexpr size_t WS_KC = 1095 * MiB;
constexpr size_t WS_VC = 1112 * MiB;
constexpr size_t WS_LNST = 1129 * MiB;
constexpr size_t WS_END = 1131 * MiB;

constexpr int CW_BAR = 4096;
constexpr int LDS_BYTES = 147456;
constexpr int RING_BYTES = 131072, MISC_OFF = RING_BYTES + 320;

struct Args { const void* in[N_IN]; float* out; unsigned char* ws; int ph_lo, ph_hi, li, pad; };

struct Frame {
    LAS unsigned char* lds;
    int tid, lane, wave, vcu, G;
};

__device__ __forceinline__ float wave_sum(float v) {
#pragma unroll
    for (int o = 1; o < 64; o <<= 1) v += __shfl_xor(v, o);
    return v;
}
__device__ __forceinline__ float bf2f(unsigned short b) { return __builtin_bit_cast(float, (unsigned)b << 16); }

__device__ __forceinline__ float gelu_tanh(float x) {
    const float t = x * (1.0f + 0.044715f * x * x) * (-2.0f * 0.7978845608028654f * 1.4426950408889634f);
    return x * __builtin_amdgcn_rcpf(1.0f + __builtin_amdgcn_exp2f(t));
}
__device__ __forceinline__ float silu_f(float x) { return x * __builtin_amdgcn_rcpf(1.0f + __builtin_amdgcn_exp2f(-1.4426950408889634f * x)); }

struct EpiGelu {
    static constexpr bool PERM = true, AFTER_DRAIN = false;
    bf16* O; int ldc;
    __device__ __forceinline__ void operator()(const pg8::f32x4 (&acc)[2][2][4][2], const pg8::Unit& u, int wr, int wc, int fr, int fq) const {
        const int row0 = u.pm * 256 + wr * 64 + fr, col0 = u.pn * 256 + wc * 32 + 8 * fq;
#pragma unroll
        for (int ai = 0; ai < 2; ++ai)
#pragma unroll
            for (int m = 0; m < 4; ++m) { bf16* rowp = O + (size_t)(row0 + ai * 128 + m * 16) * ldc + col0;
#pragma unroll
                for (int bj = 0; bj < 2; ++bj) { const pg8::f32x4 v0 = acc[ai][bj][m][0], v1 = acc[ai][bj][m][1];
                    v4u w; w.x = pg8::cvt_pk_bf16(gelu_tanh(v0[0]), gelu_tanh(v0[1])); w.y = pg8::cvt_pk_bf16(gelu_tanh(v0[2]), gelu_tanh(v0[3]));
                    w.z = pg8::cvt_pk_bf16(gelu_tanh(v1[0]), gelu_tanh(v1[1])); w.w = pg8::cvt_pk_bf16(gelu_tanh(v1[2]), gelu_tanh(v1[3]));
                    *(v4u*)(rowp + bj * 128) = w; } }
    }
};
struct EpiSwiglu {
    static constexpr bool PERM = true, AFTER_DRAIN = false;
    bf16* O; int ldc;
    __device__ __forceinline__ void operator()(const pg8::f32x4 (&acc)[2][2][4][2], const pg8::Unit& u, int wr, int wc, int fr, int fq) const {
        typedef unsigned u32x2v __attribute__((ext_vector_type(2)));
        const int row0 = u.pm * 256 + wr * 64 + fr, col0 = (u.pn * 256 + wc * 32 + 8 * fq) >> 1;
#pragma unroll
        for (int ai = 0; ai < 2; ++ai)
#pragma unroll
            for (int m = 0; m < 4; ++m) { bf16* rowp = O + (size_t)(row0 + ai * 128 + m * 16) * ldc + col0;
#pragma unroll
                for (int bj = 0; bj < 2; ++bj) { const pg8::f32x4 g = acc[ai][bj][m][0], up = acc[ai][bj][m][1];
                    u32x2v w; w.x = pg8::cvt_pk_bf16(silu_f(g[0]) * up[0], silu_f(g[1]) * up[1]); w.y = pg8::cvt_pk_bf16(silu_f(g[2]) * up[2], silu_f(g[3]) * up[3]);
                    *(u32x2v*)(rowp + bj * 64) = w; } }
    }
};
struct EpiResid {
    static constexpr bool PERM = false, AFTER_DRAIN = false;
    float* H; int ldc;
    __device__ __forceinline__ void operator()(const pg8::f32x4 (&acc)[2][2][4][2], const pg8::Unit& u, int wr, int wc, int fr, int fq) const {
        const int row0 = u.pm * 256 + wr * 64 + fr, col0 = u.pn * 256 + wc * 32 + 4 * fq;
#pragma unroll
        for (int ai = 0; ai < 2; ++ai)
#pragma unroll
            for (int m = 0; m < 4; ++m) { float* rowp = H + (size_t)(row0 + ai * 128 + m * 16) * ldc + col0;
#pragma unroll
                for (int bj = 0; bj < 2; ++bj)
#pragma unroll
                    for (int n = 0; n < 2; ++n) { pg8::f32x4* p = (pg8::f32x4*)(rowp + bj * 128 + n * 16); *p = *p + acc[ai][bj][m][n]; } }
    }
};
struct EpiRaw {
    static constexpr bool PERM = false, AFTER_DRAIN = false;
    float* P; int ldc;
    __device__ __forceinline__ void operator()(const pg8::f32x4 (&acc)[2][2][4][2], const pg8::Unit& u, int wr, int wc, int fr, int fq) const {
        const int row0 = u.pm * 256 + wr * 64 + fr, col0 = u.pn * 256 + wc * 32 + 4 * fq;
#pragma unroll
        for (int ai = 0; ai < 2; ++ai)
#pragma unroll
            for (int m = 0; m < 4; ++m) { float* rowp = P + (size_t)(row0 + ai * 128 + m * 16) * ldc + col0;
#pragma unroll
                for (int bj = 0; bj < 2; ++bj)
#pragma unroll
                    for (int n = 0; n < 2; ++n) *(pg8::f32x4*)(rowp + bj * 128 + n * 16) = acc[ai][bj][m][n]; }
    }
};

struct WJob { const float* src; const float* src2; const float* gain; const float* gain2; bf16* dst; int Nsrc, Nsrc2, K, Nphys, kind; };
struct WSrc { const float* p; const float* gain; int col, N; };
__device__ __forceinline__ WSrc wmap(const WJob& j, int p) {
    WSrc s; s.p = j.src; s.gain = j.gain; s.N = j.Nsrc; s.col = p;
    if (j.kind == 1) { const int w = p & 7; s.col = (p >> 3) * 4 + (w & 3); if (w >= 4) s.p = j.src2; }
    else if (j.kind == 2 || j.kind == 3) {
        const int ti = p >> 8, q = p & 255, wc = (q & 127) >> 5, d = 32 * (q >> 7) + (q & 31), head = 4 * ti + wc;
        const int nkv = (j.kind == 2) ? 24 : 0;
        if (head < nkv) { s.col = 64 * head + d; }
        else if (head < nkv + 16) { s.col = 64 * (head - nkv) + d; if (j.kind == 2) { s.p = j.src2; s.gain = j.gain2; s.N = j.Nsrc2; } }
        else { if (j.kind == 2) { s.p = j.src2; s.gain = j.gain2; s.N = j.Nsrc2; } s.col = (q < 48) ? 1024 + q : -1; }
    }
    return s;
}
__device__ __forceinline__ void conv_item(const WJob& j, int item, LAS float* scr, int lane) {
    const int nblk = j.Nphys / 32, kb = item / nblk, nb = item % nblk, k0 = 64 * kb, p0 = 32 * nb;
    const WSrc s = wmap(j, p0 + (lane & 31));
#pragma unroll 8
    for (int i = 0; i < 32; ++i) { const int kk = 2 * i + (lane >> 5); float v = 0.f;
        if (s.col >= 0) { v = s.p[(size_t)(k0 + kk) * s.N + s.col]; if (s.gain) v *= s.gain[k0 + kk]; }
        scr[kk * 33 + (lane & 31)] = v; }
    asm volatile("s_waitcnt lgkmcnt(0)" ::: "memory");
    const int c = lane & 7;
#pragma unroll
    for (int jj = 0; jj < 4; ++jj) { const int n = (lane >> 3) + 8 * jj; const LAS float* sp = scr + (8 * c) * 33 + n;
        v4u o; o.x = pk2(sp[0 * 33], sp[1 * 33]); o.y = pk2(sp[2 * 33], sp[3 * 33]); o.z = pk2(sp[4 * 33], sp[5 * 33]); o.w = pk2(sp[6 * 33], sp[7 * 33]);
        *(GAS v4u*)(j.dst + (size_t)(p0 + n) * j.K + k0 + 8 * c) = o; }
    asm volatile("s_waitcnt lgkmcnt(0)" ::: "memory");
}
constexpr int NJOBS = 16;
__device__ __forceinline__ WJob get_job(const Args& a, int j) {
    const float* const* in = (const float* const*)a.in; unsigned char* ws = a.ws;
    WJob w; w.src2 = nullptr; w.gain = nullptr; w.gain2 = nullptr; w.Nsrc2 = 0; w.kind = 0;
    if (j < 2)       { const int l = j;      w.src = in[I_AWIN] + (size_t)l * DM * 4096; w.gain = in[I_NMIX] + l * DM; w.dst = (bf16*)(ws + WS_WIN) + (size_t)l * 4096 * DM; w.Nsrc = 4096; w.K = DM; w.Nphys = 4096; }
    else if (j < 4)  { const int l = j - 2;  w.src = in[I_AWOUT] + (size_t)l * DA * DM; w.dst = (bf16*)(ws + WS_WOUTA) + (size_t)l * DM * DA; w.Nsrc = DM; w.K = DA; w.Nphys = DM; }
    else if (j < 8)  { const int l = j - 4;  w.src = in[I_WG] + (size_t)l * DM * DFF; w.src2 = in[I_WU] + (size_t)l * DM * DFF; w.gain = in[I_NFFN] + l * DM; w.dst = (bf16*)(ws + WS_WGU) + (size_t)l * 2 * DFF * DM; w.Nsrc = DFF; w.K = DM; w.Nphys = 2 * DFF; w.kind = 1; }
    else if (j < 12) { const int l = j - 8;  w.src = in[I_WD] + (size_t)l * DFF * DM; w.dst = (bf16*)(ws + WS_WD) + (size_t)l * DM * DFF; w.Nsrc = DM; w.K = DFF; w.Nphys = DM; }
    else if (j == 12) { w.src = in[I_KVW]; w.gain = in[I_KVN]; w.Nsrc = 1536; w.src2 = in[I_BWIN]; w.gain2 = in[I_NMIX] + 2 * DM; w.Nsrc2 = 1072; w.dst = (bf16*)(ws + WS_WKVQ); w.K = DM; w.Nphys = NKVQ; w.kind = 2; }
    else if (j == 13) { w.src = in[I_BWIN] + (size_t)DM * 1072; w.gain = in[I_NMIX] + 3 * DM; w.Nsrc = 1072; w.dst = (bf16*)(ws + WS_WQ3); w.K = DM; w.Nphys = NQ3; w.kind = 3; }
    else { const int l = j - 14; w.src = in[I_BWOUT] + (size_t)l * DM * DM; w.dst = (bf16*)(ws + WS_WOB) + (size_t)l * DM * DM; w.Nsrc = DM; w.K = DM; w.Nphys = DM; }
    return w;
}
__device__ __forceinline__ void phase_prologue(const Frame& F, const Args& a) {
    LAS float* scr = (LAS float*)(F.lds + F.wave * 16384);
    const int gw = F.vcu * NWAVES + F.wave, NGW = F.G * NWAVES;
    int base = 0;
    for (int j = 0; j < NJOBS; ++j) {
        const WJob w = get_job(a, j);
        const int n = (w.K / 64) * (w.Nphys / 32);
        int it = (gw - base) % NGW; if (it < 0) it += NGW;
        for (; it < n; it += NGW) conv_item(w, it, scr, F.lane);
        base = (base + n) % NGW;
    }
    const int gt = F.vcu * NTHR + F.tid, NGT = F.G * NTHR;
    const f32x4* xp = (const f32x4*)a.in[I_XP]; const f32x4* xs = (const f32x4*)a.in[I_XS]; f32x4* H = (f32x4*)(a.out + O_Y);
    for (size_t i = gt; i < (size_t)M * DM / 4; i += NGT) H[i] = (i < (size_t)MP * DM / 4) ? xp[i] : xs[i - (size_t)MP * DM / 4];
    const f32x4* sw = (const f32x4*)a.in[I_SWIN]; f32x4* wo = (f32x4*)(a.out + O_WINS);
    for (size_t i = gt; i < (size_t)128 * 508 * 128; i += NGT) { const size_t s = i / (508 * 128), r = i % (508 * 128); wo[s * 512 * 128 + r] = sw[s * 512 * 128 + 4 * 128 + r]; }
}

__device__ __forceinline__ void phase_norm(const Frame& F, const float* H, bf16* XN) {
    const int gw = F.vcu * NWAVES + F.wave, NGW = F.G * NWAVES;
    for (int m = gw; m < M; m += NGW) {
        const f32x4* xr = (const f32x4*)(H + (size_t)m * DM) + F.lane;
        f32x4 v[4]; float s = 0.f;
#pragma unroll
        for (int j = 0; j < 4; ++j) { v[j] = xr[64 * j]; s += (v[j].x * v[j].x + v[j].y * v[j].y) + (v[j].z * v[j].z + v[j].w * v[j].w); }
        const float rstd = 1.0f / sqrtf(wave_sum(s) * (1.f / DM) + EPS);
        unsigned long long* o8 = (unsigned long long*)(XN + (size_t)m * DM) + F.lane;
#pragma unroll
        for (int j = 0; j < 4; ++j) o8[64 * j] = (unsigned long long)pk2(v[j].x * rstd, v[j].y * rstd) | ((unsigned long long)pk2(v[j].z * rstd, v[j].w * rstd) << 32);
    }
}
__device__ __forceinline__ void phase_lnstat(const Frame& F, const bf16* UV, float* LNST) {
    const int gw = F.vcu * NWAVES + F.wave, NGW = F.G * NWAVES;
    for (int m = gw; m < M; m += NGW) {
        const v4u* vr = (const v4u*)(UV + (size_t)m * 4096 + 2048) + F.lane;
        float x[32]; float s = 0.f;
#pragma unroll
        for (int j = 0; j < 4; ++j) { const v4u w = vr[64 * j];
#pragma unroll
            for (int e = 0; e < 4; ++e) { const unsigned ww = w[e]; x[8 * j + 2 * e] = __builtin_bit_cast(float, ww << 16); x[8 * j + 2 * e + 1] = __builtin_bit_cast(float, ww & 0xffff0000u); } }
#pragma unroll
        for (int i = 0; i < 32; ++i) s += x[i];
        const float mean = wave_sum(s) * (1.f / DA); float q = 0.f;
#pragma unroll
        for (int i = 0; i < 32; ++i) { const float d = x[i] - mean; q += d * d; }
        const float rstd = 1.0f / sqrtf(wave_sum(q) * (1.f / DA) + EPS);
        if (F.lane == 0) { LNST[2 * m] = mean; LNST[2 * m + 1] = rstd; }
    }
}
__device__ __forceinline__ void phase_spatial_naive(const Frame& F, const Args& a, int l) {
    const bf16* UV = (const bf16*)(a.ws + WS_UV); const float* LNST = (const float*)(a.ws + WS_LNST); bf16* GT = (bf16*)(a.ws + WS_GATED);
    const float* lng = (const float*)a.in[I_ALNG] + l * DA; const float* lnb = (const float*)a.in[I_ALNB] + l * DA;
    const float* ws = (const float*)a.in[I_AWS] + (size_t)l * 8 * 128 * 128; const float* bs = (const float*)a.in[I_ABS] + l * 8 * 128;
    float* av = a.out + O_AV + (size_t)l * 128 * 4 * DA;
    const int gt = F.vcu * NTHR + F.tid, NGT = F.G * NTHR;
    for (size_t it = gt; it < (size_t)M * 256; it += NGT) {
        const int row = (int)(it >> 8), c = (int)(it & 255) * 8, g = c >> 8;
        const int tt = (row < MP) ? (row & 127) : ((row - MP) & 3), r0 = row - tt;
        float gg[8], bb[8], acc[8];
#pragma unroll
        for (int i = 0; i < 8; ++i) { gg[i] = lng[c + i]; bb[i] = lnb[c + i]; acc[i] = 0.f; }
        const float* wrow = ws + ((size_t)g * 128 + tt) * 128;
        float own[8];
        for (int s = 0; s <= tt; ++s) {
            const float w = wrow[s], mean = LNST[2 * (r0 + s)], rstd = LNST[2 * (r0 + s) + 1];
            const v4u vv = *(const v4u*)(UV + (size_t)(r0 + s) * 4096 + 2048 + c);
#pragma unroll
            for (int e = 0; e < 4; ++e) { const unsigned ww = vv[e];
                const float v0 = (__builtin_bit_cast(float, ww << 16) - mean) * rstd * gg[2 * e] + bb[2 * e];
                const float v1 = (__builtin_bit_cast(float, ww & 0xffff0000u) - mean) * rstd * gg[2 * e + 1] + bb[2 * e + 1];
                acc[2 * e] += w * v0; acc[2 * e + 1] += w * v1; own[2 * e] = v0; own[2 * e + 1] = v1; }
        }
        const float bst = bs[g * 128 + tt];
        const v4u uu = *(const v4u*)(UV + (size_t)row * 4096 + c);
        v4u o;
#pragma unroll
        for (int e = 0; e < 4; ++e) { const unsigned ww = uu[e];
            o[e] = pk2(__builtin_bit_cast(float, ww << 16) * (acc[2 * e] + bst), __builtin_bit_cast(float, ww & 0xffff0000u) * (acc[2 * e + 1] + bst)); }
        *(v4u*)(GT + (size_t)row * DA + c) = o;
        if (row >= MP) { float* ap = av + (size_t)(row - MP) * DA + c; *(f32x4*)ap = (f32x4){own[0], own[1], own[2], own[3]}; *(f32x4*)(ap + 4) = (f32x4){own[4], own[5], own[6], own[7]}; }
    }
}

__device__ __forceinline__ void row_pos(int row, int& seq, int& pos) {
    if (row < MP) { seq = row >> 11; pos = row & 2047; } else { seq = 8 + ((row - MP) >> 2); pos = 2048 + ((row - MP) & 3); }
}
__device__ __forceinline__ void rope_cs(int pos, int i, float& c, float& s) {
    const double inv[8] = {1.0, 0.19392274474868576, 0.03760603093086393, 0.007292664737217109, 0.001414213562373095, 0.0002742481756762073, 5.318295896944988e-05, 1.031338537721246e-05};
    double f = inv[0];
#pragma unroll
    for (int k = 1; k < 8; ++k) f = (i == k) ? inv[k] : f;
    const double ang = (double)pos * f; const double n = __builtin_rint(ang * 0.15915494309189535); const float r = (float)(ang - n * 6.283185307179586);
    c = cosf(r); s = sinf(r);
}
__device__ __forceinline__ void phase_post_naive(const Frame& F, const Args& a, int l) {
    const int ldp = (l == 2) ? NKVQ : NQ3, nkv = (l == 2) ? 24 : 0, nslot = nkv + 17;
    const float* P = (const float*)(a.ws + WS_PROJ);
    float* QN = (float*)(a.ws + WS_QN); float* QR = (float*)(a.ws + WS_QR); float* GA = (float*)(a.ws + WS_GATES); float* KVW = (float*)(a.ws + WS_KVWIN);
    const float* qnw = (const float*)a.in[I_BQN] + (l - 2) * 64;
    const int gt = F.vcu * NTHR + F.tid, NGT = F.G * NTHR;
    for (size_t it = gt; it < (size_t)M * nslot; it += NGT) {
        const int row = (int)(it / nslot), slot = (int)(it % nslot);
        int seq, pos; row_pos(row, seq, pos);
        const float* pr = P + (size_t)row * ldp;
        if (slot == nkv + 16) {
            const float* gp = pr + (nkv / 4 + 4) * 256;
            for (int i = 0; i < 48; ++i) GA[(size_t)row * 48 + i] = 1.0f / (1.0f + expf(-gp[i]));
            continue;
        }
        const int ti = slot >> 2, wc = slot & 3;
        float x[64];
#pragma unroll
        for (int i = 0; i < 16; ++i) { const int d = 4 * i; const f32x4 v = *(const f32x4*)(pr + ti * 256 + 128 * (d >> 5) + 32 * wc + (d & 31)); x[d] = v.x; x[d + 1] = v.y; x[d + 2] = v.z; x[d + 3] = v.w; }
        const float* nw = nullptr; bool do_rope = false; float* dst = nullptr; float* dst2 = nullptr; float* dst3 = nullptr;
        if (slot < nkv) {
            const int br = slot >> 3, kvsel = (slot >> 2) & 1, g = slot & 3; const int off = kvsel * 256 + g * 64;
            if (br == 0) dst = a.out + O_KVCMP + (size_t)row * 512 + off;
            else if (br == 1) { dst = a.out + O_KVSLC + (size_t)row * 512 + off; if (!kvsel) { nw = (const float*)a.in[I_KNS]; do_rope = true; } }
            else { dst = KVW + (size_t)row * 512 + off; if (!kvsel) { nw = (const float*)a.in[I_KNW]; do_rope = true; }
                if (row < MP) { if (pos >= SEQ - 512) dst2 = a.out + O_WINP + ((size_t)seq * 512 + (pos - (SEQ - 512))) * 512 + off; }
                else dst2 = a.out + O_WINS + ((size_t)(seq - 8) * 512 + 508 + (pos - 2048)) * 512 + off; }
        } else { const int h = slot - nkv; nw = qnw; dst = QN + (size_t)row * DM + h * 64; dst3 = QR + (size_t)row * DM + h * 64; do_rope = true; }
        if (nw) { float ss = 0.f;
#pragma unroll
            for (int d = 0; d < 64; ++d) ss += x[d] * x[d];
            const float rs = 1.0f / sqrtf(ss * (1.f / 64) + EPS);
#pragma unroll
            for (int d = 0; d < 64; ++d) x[d] = x[d] * rs * nw[d]; }
        if (dst3) {
#pragma unroll
            for (int i = 0; i < 16; ++i) *(f32x4*)(dst + 4 * i) = (f32x4){x[4 * i], x[4 * i + 1], x[4 * i + 2], x[4 * i + 3]};
            dst = dst3;
        }
        if (do_rope) {
#pragma unroll
            for (int i = 0; i < 8; ++i) { float c, s; rope_cs(pos, i, c, s); const float x1 = x[i], x2 = x[8 + i]; x[i] = x1 * c - x2 * s; x[8 + i] = x2 * c + x1 * s; }
        }
#pragma unroll
        for (int i = 0; i < 16; ++i) { const f32x4 v = (f32x4){x[4 * i], x[4 * i + 1], x[4 * i + 2], x[4 * i + 3]}; *(f32x4*)(dst + 4 * i) = v; if (dst2) *(f32x4*)(dst2 + 4 * i) = v; }
    }
}
__device__ __forceinline__ void phase_compress_naive(const Frame& F, const Args& a) {
    const int gw = F.vcu * NWAVES + F.wave, NGW = F.G * NWAVES, e = F.lane;
    const int* pt = (const int*)a.in[I_PT]; const float* cc = (const float*)a.in[I_CCMP];
    const float* knc = (const float*)a.in[I_KNC];
    for (int it = gw; it < 136 * 127 * 4 * 2; it += NGW) {
        const int which = it & 1, g = (it >> 1) & 3, n = (it >> 3) % 127, seq = (it >> 3) / 127;
        const float* w = (const float*)a.in[which ? I_CWV : I_CWK]; const float* posw = (const float*)a.in[which ? I_CPV : I_CPK];
        float acc = 0.f;
        for (int ll = 0; ll < 32; ++ll) {
            const int r = 16 * n + ll; const float* rp;
            if (seq < 8) rp = a.out + O_KVCMP + ((size_t)seq * SEQ + r) * 512;
            else rp = cc + ((size_t)pt[(seq - 8) * 16 + (r >> 7)] * 128 + (r & 127)) * 512;
            const float x = rp[which * 256 + g * 64 + e] + posw[ll * 64 + e];
            const float* wl = w + (size_t)ll * 4096 + e;
#pragma unroll
            for (int d = 0; d < 64; ++d) acc += __builtin_bit_cast(float, __builtin_amdgcn_readlane(__builtin_bit_cast(int, x), d)) * wl[d * 64];
        }
        float* dst = (float*)(a.ws + (which ? WS_VC : WS_KC)) + (((size_t)seq * 127 + n) * 4 + g) * 64;
        if (!which) { const float ss = wave_sum(acc * acc); acc = acc * (1.0f / sqrtf(ss * (1.f / 64) + EPS)) * knc[e]; }
        dst[e] = acc;
    }
}
__device__ __forceinline__ void load64(const float* p, float (&q)[64]) {
#pragma unroll
    for (int i = 0; i < 16; ++i) { const f32x4 v = *(const f32x4*)(p + 4 * i); q[4 * i] = v.x; q[4 * i + 1] = v.y; q[4 * i + 2] = v.z; q[4 * i + 3] = v.w; }
}
__device__ __forceinline__ float dot64(const float (&q)[64], const float* k) {
    float s0 = 0.f, s1 = 0.f, s2 = 0.f, s3 = 0.f;
#pragma unroll
    for (int i = 0; i < 16; ++i) { const f32x4 v = *(const f32x4*)(k + 4 * i); s0 += q[4 * i] * v.x; s1 += q[4 * i + 1] * v.y; s2 += q[4 * i + 2] * v.z; s3 += q[4 * i + 3] * v.w; }
    return (s0 + s1) + (s2 + s3);
}
__device__ __forceinline__ void axpy64(float (&o)[64], float p, const float* v) {
#pragma unroll
    for (int i = 0; i < 16; ++i) { const f32x4 x = *(const f32x4*)(v + 4 * i); o[4 * i] += p * x.x; o[4 * i + 1] += p * x.y; o[4 * i + 2] += p * x.z; o[4 * i + 3] += p * x.w; }
}
__device__ __forceinline__ void phase_acmp_naive(const Frame& F, const Args& a) {
    const float* QN = (const float*)(a.ws + WS_QN); const float* KC = (const float*)(a.ws + WS_KC); const float* VC = (const float*)(a.ws + WS_VC);
    float* PC = (float*)(a.ws + WS_PCMP); float* OC = (float*)(a.ws + WS_OC);
    const int gt = F.vcu * NTHR + F.tid, NGT = F.G * NTHR;
    for (size_t it = gt; it < (size_t)M * 16; it += NGT) {
        const int row = (int)(it >> 4), head = (int)(it & 15), g = head >> 2;
        int seq, pos; row_pos(row, seq, pos);
        float q[64]; load64(QN + (size_t)row * DM + head * 64, q);
        float* pc = PC + ((size_t)row * 16 + head) * 128;
        const int nv = (pos >= 31) ? min(127, (pos - 31) / 16 + 1) : 0;
        float m = -INFINITY;
        for (int n = 0; n < nv; ++n) { const float s = dot64(q, KC + (((size_t)seq * 127 + n) * 4 + g) * 64) * 0.125f; pc[n] = s; m = fmaxf(m, s); }
        float lsum = 0.f;
        for (int n = 0; n < nv; ++n) lsum += expf(pc[n] - m);
        const float inv = 1.0f / fmaxf(lsum, 1e-30f);
        float o[64];
#pragma unroll
        for (int d = 0; d < 64; ++d) o[d] = 0.f;
        for (int n = 0; n < nv; ++n) { const float p = expf(pc[n] - m) * inv; pc[n] = p; axpy64(o, p, VC + (((size_t)seq * 127 + n) * 4 + g) * 64); }
        for (int n = nv; n < 128; ++n) pc[n] = 0.f;
        float* op = OC + (size_t)row * DM + head * 64;
#pragma unroll
        for (int i = 0; i < 16; ++i) *(f32x4*)(op + 4 * i) = (f32x4){o[4 * i], o[4 * i + 1], o[4 * i + 2], o[4 * i + 3]};
    }
}
__device__ __forceinline__ void phase_asel_naive(const Frame& F, const Args& a) {
    const float* PC = (const float*)(a.ws + WS_PCMP); float* SC = (float*)(a.ws + WS_SCORE); unsigned long long* SM = (unsigned long long*)(a.ws + WS_SELM);
    const int gt = F.vcu * NTHR + F.tid, NGT = F.G * NTHR;
    for (size_t it = gt; it < (size_t)M * 4; it += NGT) {
        const int row = (int)(it >> 2), g = (int)(it & 3);
        int seq, pos; row_pos(row, seq, pos);
        const int nsel = (row < MP) ? 32 : 33, cur = pos >> 6;
        float* sc = SC + (size_t)it * 40;
        const float* pc = PC + ((size_t)row * 16 + g * 4) * 128;
        for (int j = 0; j < nsel; ++j) {
            float imp = 0.f;
            for (int n = max(0, 4 * j - 1); n <= min(126, 4 * j + 3); ++n) imp += (pc[n] + pc[128 + n]) + (pc[256 + n] + pc[384 + n]);
            const bool forced = (j == 0) || (j == cur) || (j == cur - 1), valid = j <= cur;
            sc[j] = forced ? INFINITY : (valid ? imp : -INFINITY);
        }
        unsigned long long mask = 0ull;
        for (int j = 0; j < nsel; ++j) { const float sj = sc[j]; int rank = 0;
            for (int i = 0; i < nsel; ++i) { const float si = sc[i]; rank += (si > sj || (si == sj && i < j)) ? 1 : 0; }
            if (rank < 16 && sj > -INFINITY) mask |= 1ull << j; }
        SM[it] = mask;
    }
}
__device__ __forceinline__ void phase_aslc_naive(const Frame& F, const Args& a) {
    const float* QR = (const float*)(a.ws + WS_QR); const unsigned long long* SM = (const unsigned long long*)(a.ws + WS_SELM); float* OS = (float*)(a.ws + WS_OS);
    const float* KVS = a.out + O_KVSLC; const float* cs = (const float*)a.in[I_CSLC]; const int* pt = (const int*)a.in[I_PT];
    const int gt = F.vcu * NTHR + F.tid, NGT = F.G * NTHR;
    for (size_t it = gt; it < (size_t)M * 16; it += NGT) {
        const int row = (int)(it >> 4), head = (int)(it & 15), g = head >> 2;
        int seq, pos; row_pos(row, seq, pos);
        float q[64]; load64(QR + (size_t)row * DM + head * 64, q);
        const unsigned long long mask = SM[(size_t)row * 4 + g];
        const int nsel = (row < MP) ? 32 : 33;
        float m = -INFINITY, lsum = 0.f, o[64];
#pragma unroll
        for (int d = 0; d < 64; ++d) o[d] = 0.f;
        for (int j = 0; j < nsel; ++j) {
            if (!((mask >> j) & 1ull)) continue;
            for (int kk = 0; kk < 64; ++kk) {
                const int key = 64 * j + kk; if (key > pos) break;
                const float* kp;
                if (row < MP) kp = KVS + ((size_t)seq * SEQ + key) * 512 + g * 64;
                else if (key < 2048) kp = cs + ((size_t)pt[(seq - 8) * 16 + (key >> 7)] * 128 + (key & 127)) * 512 + g * 64;
                else kp = KVS + ((size_t)MP + (seq - 8) * 4 + (key - 2048)) * 512 + g * 64;
                const float s = dot64(q, kp) * 0.125f;
                if (s > m) { const float f = expf(m - s); lsum *= f;
#pragma unroll
                    for (int d = 0; d < 64; ++d) o[d] *= f;
                    m = s; }
                const float p = expf(s - m); lsum += p; axpy64(o, p, kp + 256);
            }
        }
        const float inv = 1.0f / fmaxf(lsum, 1e-30f);
        float* op = OS + (size_t)row * DM + head * 64;
#pragma unroll
        for (int i = 0; i < 16; ++i) *(f32x4*)(op + 4 * i) = (f32x4){o[4 * i] * inv, o[4 * i + 1] * inv, o[4 * i + 2] * inv, o[4 * i + 3] * inv};
    }
}
__device__ __forceinline__ void phase_awin_naive(const Frame& F, const Args& a) {
    const float* QR = (const float*)(a.ws + WS_QR); const float* OC = (const float*)(a.ws + WS_OC); const float* OS = (const float*)(a.ws + WS_OS);
    const float* GA = (const float*)(a.ws + WS_GATES); const float* KVW = (const float*)(a.ws + WS_KVWIN); const float* sw = (const float*)a.in[I_SWIN];
    bf16* O = (bf16*)(a.ws + WS_O);
    const int gt = F.vcu * NTHR + F.tid, NGT = F.G * NTHR;
    for (size_t it = gt; it < (size_t)M * 16; it += NGT) {
        const int row = (int)(it >> 4), head = (int)(it & 15), g = head >> 2;
        int seq, pos; row_pos(row, seq, pos);
        float q[64]; load64(QR + (size_t)row * DM + head * 64, q);
        float m = -INFINITY, lsum = 0.f, o[64];
#pragma unroll
        for (int d = 0; d < 64; ++d) o[d] = 0.f;
        for (int key = max(0, pos - 511); key <= pos; ++key) {
            const float* kp;
            if (row < MP) kp = KVW + ((size_t)seq * SEQ + key) * 512 + g * 64;
            else if (key < 2048) kp = sw + ((size_t)(seq - 8) * 512 + (key - 1536)) * 512 + g * 64;
            else kp = KVW + ((size_t)MP + (seq - 8) * 4 + (key - 2048)) * 512 + g * 64;
            const float s = dot64(q, kp) * 0.125f;
            if (s > m) { const float f = expf(m - s); lsum *= f;
#pragma unroll
                for (int d = 0; d < 64; ++d) o[d] *= f;
                m = s; }
            const float p = expf(s - m); lsum += p; axpy64(o, p, kp + 256);
        }
        const float inv = 1.0f / fmaxf(lsum, 1e-30f);
        const float g0 = GA[(size_t)row * 48 + head * 3], g1 = GA[(size_t)row * 48 + head * 3 + 1], g2 = GA[(size_t)row * 48 + head * 3 + 2] * inv;
        const float* oc = OC + (size_t)row * DM + head * 64; const float* os = OS + (size_t)row * DM + head * 64;
        bf16* op = O + (size_t)row * DM + head * 64;
#pragma unroll
        for (int i = 0; i < 8; ++i) { const f32x4 c0 = *(const f32x4*)(oc + 8 * i), c1 = *(const f32x4*)(oc + 8 * i + 4), s0 = *(const f32x4*)(os + 8 * i), s1 = *(const f32x4*)(os + 8 * i + 4);
            v4u w;
            w.x = pk2(g0 * c0.x + g1 * s0.x + g2 * o[8 * i], g0 * c0.y + g1 * s0.y + g2 * o[8 * i + 1]);
            w.y = pk2(g0 * c0.z + g1 * s0.z + g2 * o[8 * i + 2], g0 * c0.w + g1 * s0.w + g2 * o[8 * i + 3]);
            w.z = pk2(g0 * c1.x + g1 * s1.x + g2 * o[8 * i + 4], g0 * c1.y + g1 * s1.y + g2 * o[8 * i + 5]);
            w.w = pk2(g0 * c1.z + g1 * s1.z + g2 * o[8 * i + 6], g0 * c1.w + g1 * s1.w + g2 * o[8 * i + 7]);
            *(v4u*)(op + 8 * i) = w; }
    }
}

constexpr int NPH = 40;
#define PH_BEGIN { const int id_ = ph++; if (lo <= id_ && id_ < hi) {
#define PH_END if (id_ + 1 < hi) xcd_barrier(bar); } }
template <int l> __device__ __forceinline__ void run_layer(const Frame& F, const Args& args, const XcdBarrier& bar, int& ph, const int lo, const int hi) {
    unsigned char* ws = args.ws;
    float* H = args.out + O_Y;
    bf16* XN = (bf16*)(ws + WS_XN);
    PH_BEGIN phase_norm(F, H, XN); PH_END
    if constexpr (l < 2) {
        PH_BEGIN { pg8::Gemm g{XN, (const bf16*)(ws + WS_WIN) + (size_t)l * 4096 * DM, M, 4096, DM}; pg8::StaticOrder S; S.init(M, 4096, F.G, (int)blockIdx.x);
            EpiGelu E{(bf16*)(ws + WS_UV), 4096}; pg8::gemm_phase<EpiGelu, pg8::StaticOrder, true, true>(F.lds, g, S, E); } PH_END
        PH_BEGIN phase_lnstat(F, (const bf16*)(ws + WS_UV), (float*)(ws + WS_LNST)); PH_END
        PH_BEGIN phase_spatial_naive(F, args, l); PH_END
        PH_BEGIN { pg8::Gemm g{(const bf16*)(ws + WS_GATED), (const bf16*)(ws + WS_WOUTA) + (size_t)l * DM * DA, M, DM, DA}; pg8::StaticOrder S; S.init(M, DM, F.G, (int)blockIdx.x);
            EpiResid E{H, DM}; pg8::gemm_phase<EpiResid, pg8::StaticOrder, true, true>(F.lds, g, S, E); } PH_END
    } else {
        PH_BEGIN { constexpr int N = (l == 2) ? NKVQ : NQ3; pg8::Gemm g{XN, (const bf16*)(ws + (l == 2 ? WS_WKVQ : WS_WQ3)), M, N, DM}; pg8::StaticOrder S; S.init(M, N, F.G, (int)blockIdx.x);
            EpiRaw E{(float*)(ws + WS_PROJ), N}; pg8::gemm_phase<EpiRaw, pg8::StaticOrder, true, true>(F.lds, g, S, E); } PH_END
        PH_BEGIN phase_post_naive(F, args, l); PH_END
        if constexpr (l == 2) { PH_BEGIN phase_compress_naive(F, args); PH_END }
        PH_BEGIN phase_acmp_naive(F, args); PH_END
        PH_BEGIN phase_asel_naive(F, args); PH_END
        PH_BEGIN phase_aslc_naive(F, args); PH_END
        PH_BEGIN phase_awin_naive(F, args); PH_END
        PH_BEGIN { pg8::Gemm g{(const bf16*)(ws + WS_O), (const bf16*)(ws + WS_WOB) + (size_t)(l - 2) * DM * DM, M, DM, DM}; pg8::StaticOrder S; S.init(M, DM, F.G, (int)blockIdx.x);
            EpiResid E{H, DM}; pg8::gemm_phase<EpiResid, pg8::StaticOrder, true, true>(F.lds, g, S, E); } PH_END
    }
    PH_BEGIN phase_norm(F, H, XN); PH_END
    PH_BEGIN { pg8::Gemm g{XN, (const bf16*)(ws + WS_WGU) + (size_t)l * 2 * DFF * DM, M, 2 * DFF, DM}; pg8::StaticOrder S; S.init(M, 2 * DFF, F.G, (int)blockIdx.x);
        EpiSwiglu E{(bf16*)(ws + WS_ACT), DFF}; pg8::gemm_phase<EpiSwiglu, pg8::StaticOrder, true, true>(F.lds, g, S, E); } PH_END
    PH_BEGIN { pg8::Gemm g{(const bf16*)(ws + WS_ACT), (const bf16*)(ws + WS_WD) + (size_t)l * DM * DFF, M, DM, DFF}; pg8::StaticOrder S; S.init(M, DM, F.G, (int)blockIdx.x);
        EpiResid E{H, DM}; pg8::gemm_phase<EpiResid, pg8::StaticOrder, true, true>(F.lds, g, S, E); } PH_END
}
__global__ void __launch_bounds__(NTHR, 2) yoco_fwd(Args args) {
    extern __shared__ __attribute__((aligned(16))) unsigned char lds[];
    Frame F;
    F.lds = (LAS unsigned char*)lds;
    F.tid = threadIdx.x; F.lane = F.tid & 63; F.wave = __builtin_amdgcn_readfirstlane(F.tid >> 6);
    F.G = gridDim.x; { const int bx = blockIdx.x; F.vcu = (F.G % 8 == 0) ? (bx % 8) * (F.G / 8) + bx / 8 : bx; }
    volatile LAS unsigned* MISC = (volatile LAS unsigned*)(F.lds + MISC_OFF);
    for (int u = F.tid; u < (LDS_BYTES - RING_BYTES) / 4; u += NTHR) ((LAS unsigned*)(F.lds + RING_BYTES))[u] = 0u;
    __syncthreads();
    const int lo = args.ph_lo, hi = args.ph_hi;
    const bool use_bar = (hi - lo) > 1;
    unsigned* barw = (unsigned*)(args.ws + WS_CTL) + CW_BAR + args.li * XCD_BAR_WORDS;
    XcdBarrier bar; bar.bar = barw; bar.x = 0; bar.st = nullptr;
    if (use_bar) bar = xcd_barrier_post(barw, MISC + 8);
    int ph = 0;
    PH_BEGIN phase_prologue(F, args); PH_END
    run_layer<0>(F, args, bar, ph, lo, hi);
    run_layer<1>(F, args, bar, ph, lo, hi);
    run_layer<2>(F, args, bar, ph, lo, hi);
    run_layer<3>(F, args, bar, ph, lo, hi);
}
#undef PH_BEGIN
#undef PH_END

#ifndef MK_SPLIT
#define MK_SPLIT 1
#endif
extern "C" void kernel_launch(void* const* d_in, const int* in_sizes, int n_in, void* d_out, int out_size, void* d_ws, size_t ws_size, hipStream_t stream) {
    static int grid = 0;
    if (grid == 0) {
        if (n_in != N_IN || (size_t)out_size != O_END || ws_size < WS_END) { fprintf(stderr, "kernel_launch: unexpected shapes (n_in %d out %d ws %zu)\n", n_in, out_size, ws_size); grid = -1; return; }
        int dev = 0, cus = 0, per_cu = 0;
        if (hipGetDevice(&dev) != hipSuccess || hipDeviceGetAttribute(&cus, hipDeviceAttributeMultiprocessorCount, dev) != hipSuccess) { grid = -1; return; }
        if (hipFuncSetAttribute((const void*)yoco_fwd, hipFuncAttributeMaxDynamicSharedMemorySize, LDS_BYTES) != hipSuccess) { fprintf(stderr, "kernel_launch: hipFuncSetAttribute failed\n"); grid = -1; return; }
        if (hipOccupancyMaxActiveBlocksPerMultiprocessor(&per_cu, (const void*)yoco_fwd, NTHR, LDS_BYTES) != hipSuccess || per_cu < 1) { fprintf(stderr, "kernel_launch: occupancy query says %d\n", per_cu); }
        (void)hipGetLastError();
        grid = cus;
    }
    if (grid < 0) return;
    if (hipMemsetAsync((char*)d_ws + WS_CTL, 0, CTL_ZERO_BYTES, stream) != hipSuccess) return;
    Args a{};
    for (int i = 0; i < N_IN; ++i) a.in[i] = d_in[i];
    a.out = (float*)d_out; a.ws = (unsigned char*)d_ws; a.pad = 0;
#if MK_SPLIT
    for (int p = 0; p < NPH; ++p) { a.ph_lo = p; a.ph_hi = p + 1; a.li = 0; hipLaunchKernelGGL(yoco_fwd, dim3(grid), dim3(NTHR), LDS_BYTES, stream, a); }
#else
    a.ph_lo = 0; a.ph_hi = NPH; a.li = 0; hipLaunchKernelGGL(yoco_fwd, dim3(grid), dim3(NTHR), LDS_BYTES, stream, a);
#endif
    const hipError_t le = hipPeekAtLastError();
    if (le != hipSuccess) fprintf(stderr, "kernel_launch: launch failed: %s\n", hipGetErrorName(le));
}
```

```cpp
#include <hip/hip_runtime.h>
#include <cstdio>
#include <cstdint>
#include <cmath>
namespace pg8 {
#define PG8_LAS __attribute__((address_space(3)))
typedef unsigned short bf16_t;
typedef short bf16x8 __attribute__((ext_vector_type(8)));
typedef float f32x4 __attribute__((ext_vector_type(4)));
typedef unsigned u32x4 __attribute__((ext_vector_type(4)));
constexpr int BM = 256, BK = 64, HALF = 128, HTB = HALF * BK * 2  , STAGE_BYTES = 8 * HTB, NXCD = 8, WGM = 8;

__host__ __device__ __forceinline__ int lds_byte(int r, int c) { const int st = (r >> 4) * 2 + (c >> 5), rr = r & 15, cc = c & 31, ob = rr * 64 + cc * 2; return st * 1024 + (ob ^ (((ob >> 9) & 1) << 5)); }
__host__ __device__ __forceinline__ void stage_rc(int b, int& R, int& C) { const int st = b / 1024, sb = b % 1024, swz = sb ^ (((sb >> 9) & 1) << 5); R = (st >> 1) * 16 + swz / 64; C = (st & 1) * 32 + (swz % 64) / 2; }
__host__ __device__ __forceinline__ int perm32(int rho) { const int n = rho >> 4, i = rho & 15; return 8 * (i >> 2) + 4 * n + (i & 3); }

struct Unit { int pm, pn; };
struct Gemm { const bf16_t* A; const bf16_t* Bt; int M, N, K, wave; };
__device__ __forceinline__ int hw_lane() { int l; asm volatile("v_mbcnt_lo_u32_b32 %0, -1, 0\n\tv_mbcnt_hi_u32_b32 %0, -1, %0" : "=v"(l)); return l; }

struct StaticOrder {
    int nM, nN, nwg, G, c;
    __host__ __device__ void init(int M, int N, int G_, int c_) { nM = M / BM; nN = N / BM; nwg = nM * nN; G = G_; c = c_; }
    __host__ __device__ bool next(int i, Unit& u) const {
        const long L = (long)i * G + c; if (L >= nwg) return false;
        int wgid = (int)L; { const int q = nwg / NXCD, r = nwg % NXCD, xcd = wgid % NXCD, off = wgid / NXCD; wgid = (xcd < r ? xcd * (q + 1) : r * (q + 1) + (xcd - r) * q) + off; }
        const int nig = WGM * nN, gid = wgid / nig, fm = gid * WGM, gsz = (nM - fm) < WGM ? (nM - fm) : WGM;
        u.pm = fm + ((wgid % nig) % gsz); u.pn = (wgid % nig) / gsz; return true;
    }
    __device__ __forceinline__ void a_ready(const Unit&) const {}
    __device__ __forceinline__ void done(const Unit&) const {}
};

__device__ __forceinline__ unsigned cvt_pk_bf16(float lo, float hi) { unsigned r; asm volatile("v_cvt_pk_bf16_f32 %0, %1, %2" : "=v"(r) : "v"(lo), "v"(hi)); return r; }
typedef float f32x2 __attribute__((ext_vector_type(2)));
__device__ __forceinline__ f32x2 gelu_pk(f32x2 v) {
    const f32x2 av = __builtin_elementwise_abs(v), d = av * 0.2316418882f + 1.0f;
    f32x2 t; t.x = __builtin_amdgcn_rcpf(d.x); t.y = __builtin_amdgcn_rcpf(d.y);
    f32x2 q = t * 0.5307027145f + (-0.7265760135f); q = q * t + 0.7107068705f; q = q * t + (-0.142248368f); q = q * t + 0.127414796f; q = q * t;
    const f32x2 s = (v * v) * (-0.72134752044f);
    f32x2 e; e.x = __builtin_amdgcn_exp2f(s.x); e.y = __builtin_amdgcn_exp2f(s.y);
    const f32x2 m = v * (q * e), r = v - m;
    f32x2 o; o.x = v.x < 0.f ? m.x : r.x; o.y = v.y < 0.f ? m.y : r.y; return o;
}

template <int ACT  > struct EpiBf16 {
    static constexpr bool PERM = true, AFTER_DRAIN = false; static_assert(ACT == 0 || ACT == 1, "EpiBf16: ACT is 0 (none) or 1 (gelu_pk)");
    bf16_t* O; int ldc; const float* bias; int split_cols; size_t split_stride; float scale0;
    __device__ __forceinline__ void operator()(const f32x4 (&acc)[2][2][4][2], const Unit& u, int wr, int wc, int fr, int fq) const {
        const int row0 = u.pm * BM + wr * 64 + fr; int colt = u.pn * BM; bf16_t* base = O;
        float sc = 1.f; if (split_cols) { const int t = colt / split_cols; base += (size_t)t * split_stride; colt -= t * split_cols; if (t == 0) sc = scale0; }
        const int col0 = colt + wc * 32 + 8 * fq, bcol0 = u.pn * BM + wc * 32 + 8 * fq;
        f32x4 bv[2][2];
#pragma unroll
        for (int bj = 0; bj < 2; ++bj)
#pragma unroll
            for (int n = 0; n < 2; ++n) bv[bj][n] = bias ? *(const f32x4*)(bias + bcol0 + bj * HALF + 4 * n) : (f32x4){0.f, 0.f, 0.f, 0.f};
#pragma unroll
        for (int ai = 0; ai < 2; ++ai)
#pragma unroll
            for (int m = 0; m < 4; ++m) { bf16_t* rowp = base + (size_t)(row0 + ai * HALF + m * 16) * ldc + col0;
#pragma unroll
                for (int bj = 0; bj < 2; ++bj) { f32x4 v0 = acc[ai][bj][m][0] + bv[bj][0], v1 = acc[ai][bj][m][1] + bv[bj][1];
                    if (ACT == 1) { f32x2 a = gelu_pk((f32x2){v0[0], v0[1]}), b = gelu_pk((f32x2){v0[2], v0[3]}), c = gelu_pk((f32x2){v1[0], v1[1]}), d = gelu_pk((f32x2){v1[2], v1[3]});
                        v0 = (f32x4){a.x, a.y, b.x, b.y}; v1 = (f32x4){c.x, c.y, d.x, d.y}; }
                    v0 = v0 * sc; v1 = v1 * sc; u32x4 w; w.x = cvt_pk_bf16(v0[0], v0[1]); w.y = cvt_pk_bf16(v0[2], v0[3]); w.z = cvt_pk_bf16(v1[0], v1[1]); w.w = cvt_pk_bf16(v1[2], v1[3]);
                    *(u32x4*)(rowp + bj * HALF) = w; } }
    }
};
template <class Epi, class Sched, bool ALIGN_EPI = false, bool SP2 = false>
__device__ __forceinline__ void gemm_phase(PG8_LAS unsigned char* lds, const Gemm g, const Sched& S, const Epi& E) {
    const int wid = g.wave, lane = hw_lane(), tid = wid * 64 + lane, wr = wid >> 2, wc = wid & 3, fr = lane & 15, fq = lane >> 4;
    const int K = g.K, nt = K / BK;
    unsigned voffA[2], voffB[2];
#pragma unroll
    for (int i = 0; i < 2; ++i) { int R, C; stage_rc(tid * 16 + i * 8192, R, C); const int Rb = Epi::PERM ? ((R & ~31) + perm32(R & 31)) : R;
        voffA[i] = (unsigned)(R * K + C) * 2u; voffB[i] = (unsigned)(Rb * K + C) * 2u; }
    const size_t kstep = (size_t)(BK * 2);
    const size_t hstep = (size_t)HALF * K * 2;
    const size_t tstep = 2 * hstep;
    const unsigned ldsw = (unsigned)wid * 1024u;
    const int aoff = lds_byte(wr * 64 + fr, fq * 8), boff = lds_byte(wc * 32 + fr, fq * 8);
#define PG8_SA(b, h) (((b) * 2 + (h)) * HTB)
#define PG8_SB(b, h) ((4 + (b) * 2 + (h)) * HTB)
#define PG8_STAGE(bufoff, gbase, voff) do { _Pragma("unroll") for (int _i = 0; _i < 2; ++_i) \
        __builtin_amdgcn_global_load_lds((const unsigned*)((const char*)(gbase) + (voff)[_i]), (PG8_LAS unsigned*)(lds + (bufoff) + ldsw + _i * 8192), 16, 0, 0); } while (0)
#define PG8_LDA(dst, b, h) do { _Pragma("unroll") for (int m = 0; m < 4; ++m) _Pragma("unroll") for (int k = 0; k < 2; ++k) dst[m][k] = *(const PG8_LAS bf16x8*)(lds + PG8_SA(b, h) + aoff + m * 2048 + k * 1024); } while (0)
#define PG8_LDB(dst, b, h) do { _Pragma("unroll") for (int n = 0; n < 2; ++n) _Pragma("unroll") for (int k = 0; k < 2; ++k) dst[n][k] = *(const PG8_LAS bf16x8*)(lds + PG8_SB(b, h) + boff + n * 2048 + k * 1024); } while (0)
#define PG8_MMA(ai, bj, At, Bt) do { __builtin_amdgcn_s_setprio(1); _Pragma("unroll") for (int m = 0; m < 4; ++m) _Pragma("unroll") for (int n = 0; n < 2; ++n) _Pragma("unroll") for (int k = 0; k < 2; ++k) \
        acc[ai][bj][m][n] = __builtin_amdgcn_mfma_f32_16x16x32_bf16(Bt[n][k], At[m][k], acc[ai][bj][m][n], 0, 0, 0); __builtin_amdgcn_s_setprio(0); } while (0)
#define PG8_WAIT_V(n) asm volatile("s_waitcnt vmcnt(" #n ")" ::: "memory")
#define PG8_WAIT_L(n) asm volatile("s_waitcnt lgkmcnt(" #n ")" ::: "memory")
#define PG8_BAR __builtin_amdgcn_s_barrier()
#define PG8_SCHED __builtin_amdgcn_sched_barrier(0)
    Unit cur, nxt; int ui = 0;
    if (!S.next(0, cur)) return;
    f32x4 acc[2][2][4][2];
#pragma unroll
    for (int a = 0; a < 2; ++a)
#pragma unroll
        for (int b = 0; b < 2; ++b)
#pragma unroll
            for (int m = 0; m < 4; ++m)
#pragma unroll
                for (int n = 0; n < 2; ++n) acc[a][b][m][n] = (f32x4){0.f, 0.f, 0.f, 0.f};
    bf16x8 At[4][2], B0[2][2], B1[2][2];
    const char* cA = (const char*)g.A + (size_t)cur.pm * tstep; const char* cB = (const char*)g.Bt + (size_t)cur.pn * tstep;
    S.a_ready(cur);
    if constexpr (SP2) {
        PG8_STAGE(PG8_SB(0, 0), cB, voffB); PG8_STAGE(PG8_SB(0, 1), cB + hstep, voffB); PG8_STAGE(PG8_SA(0, 0), cA, voffA); PG8_STAGE(PG8_SA(0, 1), cA + hstep, voffA);
        if (wr == 1) PG8_BAR;
        PG8_WAIT_V(2); PG8_BAR;
        PG8_STAGE(PG8_SB(1, 0), cB + kstep, voffB); PG8_STAGE(PG8_SA(1, 0), cA + kstep, voffA); PG8_STAGE(PG8_SB(1, 1), cB + hstep + kstep, voffB);
        PG8_WAIT_V(6); PG8_BAR;
    } else {
        PG8_STAGE(PG8_SB(0, 0), cB, voffB); PG8_STAGE(PG8_SA(0, 0), cA, voffA); PG8_STAGE(PG8_SB(0, 1), cB + hstep, voffB); PG8_STAGE(PG8_SA(0, 1), cA + hstep, voffA);
        if (wr == 1) PG8_BAR;
        PG8_WAIT_V(4); PG8_BAR;
        PG8_STAGE(PG8_SB(1, 0), cB + kstep, voffB); PG8_STAGE(PG8_SA(1, 0), cA + kstep, voffA); PG8_STAGE(PG8_SB(1, 1), cB + hstep + kstep, voffB);
        PG8_WAIT_V(6); PG8_BAR;
    }
    for (;;) {
        const bool has_next = S.next(ui + 1, nxt);
        const char* nA = has_next ? (const char*)g.A + (size_t)nxt.pm * tstep : cA; const char* nB = has_next ? (const char*)g.Bt + (size_t)nxt.pn * tstep : cB;
        for (int t = 0; t < nt; t += 2) {
            const bool last = (t == nt - 2);
            const char* a1 = cA + (size_t)(t + 1) * kstep;
            const char* a2 = last ? nA : cA + (size_t)(t + 2) * kstep; const char* b2 = last ? nB : cB + (size_t)(t + 2) * kstep;
            const char* a3 = a2 + kstep; const char* b3 = b2 + kstep;
            if (last && has_next) S.a_ready(nxt);
            if constexpr (SP2) {
            PG8_LDB(B0, 0, 0); PG8_LDB(B1, 0, 1); PG8_SCHED; PG8_LDA(At, 0, 0); PG8_STAGE(PG8_SA(1, 1), a1 + hstep, voffA);
            PG8_WAIT_V(8); PG8_WAIT_L(0); PG8_BAR; PG8_MMA(0, 0, At, B0); PG8_MMA(0, 1, At, B1); PG8_BAR; PG8_SCHED;
            PG8_LDA(At, 0, 1); PG8_STAGE(PG8_SB(0, 0), b2, voffB); PG8_STAGE(PG8_SB(0, 1), b2 + hstep, voffB); PG8_STAGE(PG8_SA(0, 0), a2, voffA);
            PG8_WAIT_V(8); PG8_WAIT_L(0); PG8_BAR; PG8_MMA(1, 0, At, B0); PG8_MMA(1, 1, At, B1); PG8_BAR; PG8_SCHED;
            PG8_LDB(B0, 1, 0); PG8_LDB(B1, 1, 1); PG8_SCHED; PG8_LDA(At, 1, 0); PG8_STAGE(PG8_SA(0, 1), a2 + hstep, voffA);
            PG8_WAIT_V(8); PG8_WAIT_L(0); PG8_BAR; PG8_MMA(0, 0, At, B0); PG8_MMA(0, 1, At, B1); PG8_BAR; PG8_SCHED;
            PG8_LDA(At, 1, 1); PG8_STAGE(PG8_SB(1, 0), b3, voffB); PG8_STAGE(PG8_SB(1, 1), b3 + hstep, voffB); PG8_STAGE(PG8_SA(1, 0), a3, voffA);
            PG8_WAIT_V(8); PG8_WAIT_L(0); PG8_BAR; PG8_MMA(1, 0, At, B0); PG8_MMA(1, 1, At, B1); PG8_BAR; PG8_SCHED;
            } else {
            PG8_LDB(B0, 0, 0); PG8_SCHED; PG8_LDA(At, 0, 0); PG8_STAGE(PG8_SA(1, 1), a1 + hstep, voffA);
            PG8_WAIT_L(8); PG8_BAR; PG8_WAIT_L(0); PG8_MMA(0, 0, At, B0); PG8_BAR; PG8_SCHED;
            PG8_LDB(B1, 0, 1); PG8_STAGE(PG8_SB(0, 0), b2, voffB);
            PG8_BAR; PG8_WAIT_L(0); PG8_MMA(0, 1, At, B1); PG8_BAR;
            PG8_LDA(At, 0, 1); PG8_STAGE(PG8_SA(0, 0), a2, voffA);
            PG8_BAR; PG8_WAIT_L(0); PG8_MMA(1, 0, At, B0); PG8_BAR; PG8_SCHED;
            PG8_STAGE(PG8_SB(0, 1), b2 + hstep, voffB);
            PG8_WAIT_V(6); PG8_BAR; PG8_MMA(1, 1, At, B1); PG8_BAR;
            PG8_LDB(B0, 1, 0); PG8_SCHED; PG8_LDA(At, 1, 0); PG8_STAGE(PG8_SA(0, 1), a2 + hstep, voffA);
            PG8_WAIT_L(8); PG8_BAR; PG8_WAIT_L(0); PG8_MMA(0, 0, At, B0); PG8_BAR; PG8_SCHED;
            PG8_LDB(B1, 1, 1); PG8_STAGE(PG8_SB(1, 0), b3, voffB);
            PG8_BAR; PG8_WAIT_L(0); PG8_MMA(0, 1, At, B1); PG8_BAR;
            PG8_LDA(At, 1, 1); PG8_STAGE(PG8_SA(1, 0), a3, voffA);
            PG8_BAR; PG8_WAIT_L(0); PG8_MMA(1, 0, At, B0); PG8_BAR; PG8_SCHED;
            PG8_STAGE(PG8_SB(1, 1), b3 + hstep, voffB);
            PG8_WAIT_V(6); PG8_BAR; PG8_MMA(1, 1, At, B1); PG8_BAR;
            }
        }
        if constexpr (ALIGN_EPI) { if (wr == 0) PG8_BAR; }
        if constexpr (!Epi::AFTER_DRAIN) { E(acc, cur, wr, wc, fr, fq); S.done(cur); }
        if (!has_next) break;
#pragma unroll
        for (int a = 0; a < 2; ++a)
#pragma unroll
            for (int b = 0; b < 2; ++b)
#pragma unroll
                for (int m = 0; m < 4; ++m)
#pragma unroll
                    for (int n = 0; n < 2; ++n) acc[a][b][m][n] = (f32x4){0.f, 0.f, 0.f, 0.f};
        cur = nxt; cA = nA; cB = nB; ++ui;
        if constexpr (ALIGN_EPI) { if (wr == 1) PG8_BAR; }
    }
    PG8_WAIT_V(0);
    if constexpr (!ALIGN_EPI) { if (wr == 0) PG8_BAR; }
    PG8_BAR;
    if constexpr (Epi::AFTER_DRAIN) { E.fused(acc, cur, wr, wc, fr, fq, lds, wid, lane); S.done(cur); }
#undef PG8_SA
#undef PG8_SB
#undef PG8_STAGE
#undef PG8_LDA
#undef PG8_LDB
#undef PG8_MMA
#undef PG8_WAIT_V
#undef PG8_WAIT_L
#undef PG8_BAR
#undef PG8_SCHED
}
}
#define GAS __attribute__((address_space(1)))
#define LAS __attribute__((address_space(3)))
typedef unsigned short bf16;
typedef unsigned v4u __attribute__((ext_vector_type(4)));
typedef float f32x4 __attribute__((ext_vector_type(4)));
typedef short bf16x8 __attribute__((ext_vector_type(8)));
typedef GAS unsigned gu32;
typedef GAS unsigned long long gu64;
#define RLX_AGENT __ATOMIC_RELAXED, __HIP_MEMORY_SCOPE_AGENT
#define LDS_WAIT() asm volatile("s_waitcnt lgkmcnt(0)" ::: "memory")
#define VM_WAIT() asm volatile("s_waitcnt vmcnt(0)" ::: "memory")
__device__ __forceinline__ unsigned long long rt() { return __builtin_amdgcn_s_memrealtime(); }
__device__ __forceinline__ unsigned f2bf(float f) { unsigned u = __builtin_bit_cast(unsigned, f); return (u + 0x7fffu + ((u >> 16) & 1u)) >> 16; }
__device__ __forceinline__ unsigned pk2(float lo, float hi) { return f2bf(lo) | (f2bf(hi) << 16); }
#define XB_TMO      128
#define XB_XCNT(j)  (256  + 64 * (j))
#define XB_XSUB(j)  (1280 + 64 * (j))
#define XB_XGEN(j)  (2304 + 64 * (j))
#define XB_TOP      3328
#define XB_TOPGEN   3392
#define XCD_BAR_WORDS 3456
#define XB_SPIN_CAP (1u << 18)

__device__ __forceinline__ unsigned xb_ld(unsigned* p)              { return __hip_atomic_load(p, __ATOMIC_RELAXED, __HIP_MEMORY_SCOPE_AGENT); }
__device__ __forceinline__ unsigned xb_add(unsigned* p, unsigned v) { return __hip_atomic_fetch_add(p, v, __ATOMIC_RELAXED, __HIP_MEMORY_SCOPE_AGENT); }
__device__ __forceinline__ unsigned xb_xcc_id() { return (unsigned)__builtin_amdgcn_s_getreg((3 << 11) | 20) & 0xFu; }
#define XB_SPIN(cond, bar) do { unsigned _sp = 0; while (cond) { __builtin_amdgcn_s_sleep(1); \
    if ((++_sp & 255u) == 0u) { if (xb_ld(&(bar)[XB_TMO])) break; if (_sp > XB_SPIN_CAP) { atomicAdd(&(bar)[XB_TMO], 1u); break; } } } } while (0)

struct XcdBarrier {
    unsigned* bar; unsigned x; int wv;
    volatile LAS unsigned* st;
};

__device__ __forceinline__ XcdBarrier xcd_barrier_post(unsigned* bar, volatile LAS unsigned* st) {
    XcdBarrier b; b.bar = bar; b.x = xb_xcc_id(); b.st = st;
    if (threadIdx.x == 0) (void)xb_add(&bar[XB_XCNT(b.x)], 1u);
    return b;
}
__device__ __forceinline__ void xcd_barrier_complete(unsigned* bar, unsigned x, unsigned& nloc, unsigned& nx) {
    const unsigned G = gridDim.x * gridDim.y * gridDim.z;
    unsigned sum, cnt, mine, sp = 0u;
    for (;;) {
        sum = 0u; cnt = 0u; mine = 0u;
#pragma unroll
        for (unsigned j = 0; j < 16; ++j) { const unsigned c = xb_ld(&bar[XB_XCNT(j)]); sum += c; cnt += (c > 0u) ? 1u : 0u; mine = (j == x) ? c : mine; }
        if (sum == G) break;
        __builtin_amdgcn_s_sleep(1);
        if ((++sp & 255u) == 0u) { if (xb_ld(&bar[XB_TMO])) break; if (sp > XB_SPIN_CAP) { atomicAdd(&bar[XB_TMO], 1u); break; } }
    }
    nloc = mine > 0u ? mine : 1u; nx = cnt > 0u ? cnt : 1u;
}

__device__ __forceinline__ void xcd_barrier(const XcdBarrier& b) {
    asm volatile("s_waitcnt vmcnt(0)" ::: "memory");
    __syncthreads();
    if (b.wv == 0 && pg8::hw_lane() == 0) {
        unsigned* bar = b.bar;
        __builtin_amdgcn_s_waitcnt(0);
        unsigned nloc = b.st[0], nx = b.st[1];
        if (nloc == 0u) { xcd_barrier_complete(bar, b.x, nloc, nx); b.st[0] = nloc; b.st[1] = nx; }
        const unsigned old = xb_add(&bar[XB_XSUB(b.x)], 1u);
        const unsigned gen = old / nloc;
        if (old + 1u == (gen + 1u) * nloc) {
            __builtin_amdgcn_fence(__ATOMIC_RELEASE, "agent");
            asm volatile("s_waitcnt vmcnt(0)" ::: "memory");
            const unsigned og = xb_add(&bar[XB_TOP], 1u);
            const unsigned tg = og / nx;
            if (og + 1u == (tg + 1u) * nx) xb_add(&bar[XB_TOPGEN], 1u);
            else XB_SPIN(xb_ld(&bar[XB_TOPGEN]) == tg, bar);
            __builtin_amdgcn_fence(__ATOMIC_ACQUIRE, "agent");
            xb_add(&bar[XB_XGEN(b.x)], 1u);
            asm volatile("s_waitcnt vmcnt(0)" ::: "memory");
        } else {
            XB_SPIN(xb_ld(&bar[XB_XGEN(b.x)]) == gen, bar);
            __builtin_amdgcn_fence(__ATOMIC_ACQUIRE, "agent");
            asm volatile("s_waitcnt vmcnt(0)" ::: "memory");
        }
    }
    __syncthreads();
}

constexpr int NWAVES = 8, NTHR = 512;
constexpr int MP = 16384, MS = 512, M = MP + MS;
constexpr int DM = 1024, DFF = 2816, DA = 2048, SEQ = 2048;
constexpr int NKVQ = 2816, NQ3 = 1280;
constexpr float EPS = 1e-6f;
constexpr size_t MiB = 1u << 20;

enum { I_XP = 0, I_XS, I_CCMP, I_CSLC, I_SWIN, I_PT, I_NMIX, I_NFFN, I_WG, I_WU, I_WD, I_AWIN, I_ALNG, I_ALNB, I_AWS, I_ABS, I_AWOUT,
       I_KVN, I_KVW, I_KNC, I_KNS, I_KNW, I_CPK, I_CPV, I_CWK, I_CWV, I_BWIN, I_BQN, I_BWOUT, N_IN };

constexpr size_t O_Y = 0;
constexpr size_t O_KVCMP = (size_t)M * DM;
constexpr size_t O_KVSLC = O_KVCMP + (size_t)M * 512;
constexpr size_t O_WINP = O_KVSLC + (size_t)M * 512;
constexpr size_t O_WINS = O_WINP + (size_t)8 * 512 * 512;
constexpr size_t O_AV = O_WINS + (size_t)128 * 512 * 512;
constexpr size_t O_END = O_AV + (size_t)2 * 128 * 4 * 2048;

constexpr size_t WS_CTL = 0, CTL_ZERO_BYTES = 1 * MiB;
constexpr size_t WS_WIN = 2 * MiB;
constexpr size_t WS_WOUTA = 18 * MiB;
constexpr size_t WS_WGU = 26 * MiB;
constexpr size_t WS_WD = 70 * MiB;
constexpr size_t WS_WKVQ = 92 * MiB;
constexpr size_t WS_WQ3 = 98 * MiB;
constexpr size_t WS_WOB = 101 * MiB;
constexpr size_t WS_XN = 112 * MiB;
constexpr size_t WS_UV = 146 * MiB;
constexpr size_t WS_GATED = 278 * MiB;
constexpr size_t WS_ACT = 344 * MiB;
constexpr size_t WS_PROJ = 435 * MiB;
constexpr size_t WS_O = 617 * MiB;
constexpr size_t WS_QN = 650 * MiB;
constexpr size_t WS_QR = 716 * MiB;
constexpr size_t WS_GATES = 782 * MiB;
constexpr size_t WS_KVWIN = 786 * MiB;
constexpr size_t WS_OC = 819 * MiB;
constexpr size_t WS_OS = 885 * MiB;
constexpr size_t WS_PCMP = 951 * MiB;
constexpr size_t WS_SCORE = 1083 * MiB;
constexpr size_t WS_SELM = 1094 * MiB;
constexpr size_t WS_KC = 1095 * MiB;
constexpr size_t WS_VC = 1112 * MiB;
constexpr size_t WS_LNST = 1129 * MiB;
constexpr size_t WS_QNB = 1131 * MiB;
constexpr size_t WS_QRB = 1164 * MiB;
constexpr size_t WS_KSB = 1197 * MiB;
constexpr size_t WS_VSB = 1205 * MiB;
constexpr size_t WS_KWB = 1213 * MiB;
constexpr size_t WS_VWB = 1221 * MiB;
constexpr size_t WS_KCB = 1229 * MiB;
constexpr size_t WS_VCB = 1238 * MiB;
constexpr size_t WS_CWT = 1247 * MiB;
constexpr size_t WS_CBIAS = 1248 * MiB;
constexpr size_t WS_SSQA = 1249 * MiB;
constexpr size_t WS_SSQB = 1251 * MiB;
constexpr size_t WS_ROPE = 1253 * MiB;
constexpr size_t WS_LNP = 1254 * MiB;
constexpr size_t WS_END = 1259 * MiB;

constexpr int CW_BAR = 4096;
constexpr int LDS_BYTES = 147456;
constexpr int RING_BYTES = 131072, MISC_OFF = LDS_BYTES - 128;

struct Args { const void* in[N_IN]; float* out; unsigned char* ws; int ph_lo, ph_hi, li, pad; };
typedef const __attribute__((address_space(4))) Args* KArgs;

struct Frame {
    LAS unsigned char* lds;
    int tid, lane, wave, vcu, G;
};

__device__ __forceinline__ float wave_sum(float v) {
#pragma unroll
    for (int o = 1; o < 64; o <<= 1) v += __shfl_xor(v, o);
    return v;
}
__device__ __forceinline__ float bf2f(unsigned short b) { return __builtin_bit_cast(float, (unsigned)b << 16); }

__device__ __forceinline__ float gelu_tanh(float x) {
    const float t = x * (1.0f + 0.044715f * x * x) * (-2.0f * 0.7978845608028654f * 1.4426950408889634f);
    return x * __builtin_amdgcn_rcpf(1.0f + __builtin_amdgcn_exp2f(t));
}
__device__ __forceinline__ float silu_f(float x) { return x * __builtin_amdgcn_rcpf(1.0f + __builtin_amdgcn_exp2f(-1.4426950408889634f * x)); }

__device__ __forceinline__ void row_rstd(const float* SSQ, int row0, float (&rs)[2][4], int fq) {
    pg8::f32x4 q[2][4];
#pragma unroll
    for (int ai = 0; ai < 2; ++ai)
#pragma unroll
        for (int m = 0; m < 4; ++m) q[ai][m] = *(const pg8::f32x4*)(SSQ + (size_t)(row0 + ai * 128 + m * 16) * 16 + 4 * fq);
#pragma unroll
    for (int ai = 0; ai < 2; ++ai)
#pragma unroll
        for (int m = 0; m < 4; ++m) { float t = (q[ai][m][0] + q[ai][m][1]) + (q[ai][m][2] + q[ai][m][3]);
            t += __shfl_xor(t, 16); t += __shfl_xor(t, 32);
            rs[ai][m] = 1.0f / sqrtf(t * (1.f / DM) + EPS); }
}
__device__ __forceinline__ float row_rstd1(const float* SSQ, int row) {
    const pg8::f32x4* p = (const pg8::f32x4*)(SSQ + (size_t)row * 16);
    const pg8::f32x4 a = p[0], b = p[1], c = p[2], d = p[3];
    const float t = ((a[0] + a[1]) + (a[2] + a[3])) + ((b[0] + b[1]) + (b[2] + b[3])) + ((c[0] + c[1]) + (c[2] + c[3])) + ((d[0] + d[1]) + (d[2] + d[3]));
    return 1.0f / sqrtf(t * (1.f / DM) + EPS);
}
struct EpiGelu {
    static constexpr bool PERM = true, AFTER_DRAIN = false;
    KArgs kp;
    __device__ __forceinline__ void operator()(const pg8::f32x4 (&acc)[2][2][4][2], const pg8::Unit& u, int wr, int wc, int fr, int fq) const {
        unsigned char* ws_ = kp->ws; bf16* O = (bf16*)(ws_ + WS_UV); constexpr int ldc = 4096; const float* SSQ = (const float*)(ws_ + WS_SSQB); float* LNP = (float*)(ws_ + WS_LNP);
        const int row0 = u.pm * 256 + wr * 64 + fr, col0 = u.pn * 256 + wc * 32 + 8 * fq;
        pg8::f32x4 qa;
        qa = *(const pg8::f32x4*)(SSQ + (size_t)row0 * 16 + 4 * fq);
#pragma unroll
        for (int ai = 0; ai < 2; ++ai)
#pragma unroll
            for (int m = 0; m < 4; ++m) { bf16* rowp = O + (size_t)(row0 + ai * 128 + m * 16) * ldc + col0;
                float tq = (qa[0] + qa[1]) + (qa[2] + qa[3]); tq += __shfl_xor(tq, 16); tq += __shfl_xor(tq, 32);
                const float r = 1.0f / sqrtf(tq * (1.f / DM) + EPS);
                if (ai * 4 + m < 7) { const int itn = ai * 4 + m + 1; qa = *(const pg8::f32x4*)(SSQ + (size_t)(row0 + (itn >> 2) * 128 + (itn & 3) * 16) * 16 + 4 * fq); }
                float sm = 0.f, sq = 0.f;
#pragma unroll
                for (int bj = 0; bj < 2; ++bj) { const pg8::f32x4 v0 = acc[ai][bj][m][0] * r, v1 = acc[ai][bj][m][1] * r;
                    float gv[8];
#pragma unroll
                    for (int i = 0; i < 4; ++i) { gv[i] = gelu_tanh(v0[i]); gv[4 + i] = gelu_tanh(v1[i]); }
#pragma unroll
                    for (int i = 0; i < 8; ++i) { sm += gv[i]; sq += gv[i] * gv[i]; }
                    v4u w; w.x = pg8::cvt_pk_bf16(gv[0], gv[1]); w.y = pg8::cvt_pk_bf16(gv[2], gv[3]); w.z = pg8::cvt_pk_bf16(gv[4], gv[5]); w.w = pg8::cvt_pk_bf16(gv[6], gv[7]);
                    *(v4u*)(rowp + bj * 128) = w; }
                if (u.pn >= 8) { sm += __shfl_xor(sm, 16); sm += __shfl_xor(sm, 32); sq += __shfl_xor(sq, 16); sq += __shfl_xor(sq, 32);
                    if (fq == 0) { float* lp = LNP + ((size_t)(row0 + ai * 128 + m * 16) * 32 + (u.pn - 8) * 4 + wc) * 2; lp[0] = sm; lp[1] = sq; } }
                asm volatile("" ::: "memory"); }
    }
};
struct EpiSwiglu {
    static constexpr bool PERM = true, AFTER_DRAIN = false;
    KArgs kp;
    __device__ __forceinline__ void operator()(const pg8::f32x4 (&acc)[2][2][4][2], const pg8::Unit& u, int wr, int wc, int fr, int fq) const {
        typedef unsigned u32x2v __attribute__((ext_vector_type(2)));
        unsigned char* ws_ = kp->ws; bf16* O = (bf16*)(ws_ + WS_ACT); constexpr int ldc = DFF; const float* SSQ = (const float*)(ws_ + WS_SSQA);
        const int row0 = u.pm * 256 + wr * 64 + fr, col0 = (u.pn * 256 + wc * 32 + 8 * fq) >> 1;
        float rs[2][4]; row_rstd(SSQ, row0, rs, fq);
#pragma unroll
        for (int ai = 0; ai < 2; ++ai)
#pragma unroll
            for (int m = 0; m < 4; ++m) { bf16* rowp = O + (size_t)(row0 + ai * 128 + m * 16) * ldc + col0; const float r = rs[ai][m];
#pragma unroll
                for (int bj = 0; bj < 2; ++bj) { const pg8::f32x4 g = acc[ai][bj][m][0] * r, up = acc[ai][bj][m][1] * r;
                    u32x2v w; w.x = pg8::cvt_pk_bf16(silu_f(g[0]) * up[0], silu_f(g[1]) * up[1]); w.y = pg8::cvt_pk_bf16(silu_f(g[2]) * up[2], silu_f(g[3]) * up[3]);
                    *(u32x2v*)(rowp + bj * 64) = w; } }
    }
};
template <bool FINAL> struct EpiResidT {
    static constexpr bool PERM = false, AFTER_DRAIN = false;
    KArgs kp; int sb;
    __device__ __forceinline__ void operator()(const pg8::f32x4 (&acc)[2][2][4][2], const pg8::Unit& u, int wr, int wc, int fr, int fq) const {
        typedef unsigned u32x2v __attribute__((ext_vector_type(2)));
        unsigned char* ws_ = kp->ws; float* Y = kp->out + O_Y; bf16* HB = (bf16*)(ws_ + WS_XN); float* SSQ = (float*)(ws_ + (sb ? WS_SSQB : WS_SSQA));
        const int row0 = u.pm * 256 + wr * 64 + fr, col0 = u.pn * 256 + wc * 32 + 4 * fq;
#pragma unroll
        for (int ai = 0; ai < 2; ++ai)
#pragma unroll
            for (int m = 0; m < 4; ++m) { const size_t ro = (size_t)(row0 + ai * 128 + m * 16) * DM + col0; float ss = 0.f;
#pragma unroll
                for (int bj = 0; bj < 2; ++bj)
#pragma unroll
                    for (int n = 0; n < 2; ++n) { u32x2v* p = (u32x2v*)(HB + ro + bj * 128 + n * 16); const u32x2v hb = *p;
                        pg8::f32x4 h; h[0] = __builtin_bit_cast(float, hb.x << 16); h[1] = __builtin_bit_cast(float, hb.x & 0xffff0000u); h[2] = __builtin_bit_cast(float, hb.y << 16); h[3] = __builtin_bit_cast(float, hb.y & 0xffff0000u);
                        h = h + acc[ai][bj][m][n];
                        if (FINAL) *(pg8::f32x4*)(Y + ro + bj * 128 + n * 16) = h;
                        else { ss += (h[0] * h[0] + h[1] * h[1]) + (h[2] * h[2] + h[3] * h[3]);
                            u32x2v w; w.x = pg8::cvt_pk_bf16(h[0], h[1]); w.y = pg8::cvt_pk_bf16(h[2], h[3]); *p = w; } }
                if (!FINAL) { ss += __shfl_xor(ss, 16); ss += __shfl_xor(ss, 32);
                    if (fq == 0) SSQ[(size_t)(row0 + ai * 128 + m * 16) * 16 + u.pn * 4 + wc] = ss; } }
    }
};
struct EpiRaw {
    static constexpr bool PERM = false, AFTER_DRAIN = false;
    float* P; int ldc; const float* SSQ;
    __device__ __forceinline__ void operator()(const pg8::f32x4 (&acc)[2][2][4][2], const pg8::Unit& u, int wr, int wc, int fr, int fq) const {
        const int row0 = u.pm * 256 + wr * 64 + fr, col0 = u.pn * 256 + wc * 32 + 4 * fq;
        float rs[2][4]; row_rstd(SSQ, row0, rs, fq);
#pragma unroll
        for (int ai = 0; ai < 2; ++ai)
#pragma unroll
            for (int m = 0; m < 4; ++m) { float* rowp = P + (size_t)(row0 + ai * 128 + m * 16) * ldc + col0;
#pragma unroll
                for (int bj = 0; bj < 2; ++bj)
#pragma unroll
                    for (int n = 0; n < 2; ++n) *(pg8::f32x4*)(rowp + bj * 128 + n * 16) = acc[ai][bj][m][n] * rs[ai][m]; }
    }
};

__device__ __forceinline__ void row_pos(int row, int& seq, int& pos) {
    if (row < MP) { seq = row >> 11; pos = row & 2047; } else { seq = 8 + ((row - MP) >> 2); pos = 2048 + ((row - MP) & 3); }
}

struct EpiHead {
    static constexpr bool PERM = false, AFTER_DRAIN = false;
    KArgs kp; int l;
    __device__ __forceinline__ void operator()(const pg8::f32x4 (&acc)[2][2][4][2], const pg8::Unit& u, int wr, int wc, int fr, int fq) const {
        typedef unsigned u32x2v __attribute__((ext_vector_type(2)));
        unsigned char* ws = kp->ws; float* out = kp->out; const float* SSQ = (const float*)(ws + WS_SSQB);
        const float* kns = (const float*)kp->in[I_KNS]; const float* knw = (const float*)kp->in[I_KNW]; const float* qnw = (const float*)kp->in[I_BQN] + (l - 2) * 64; const int nkv = (l == 2) ? 24 : 0;
        const int row0 = u.pm * 256 + wr * 64 + fr, slot = 4 * u.pn + wc;
        float rs[2][4]; row_rstd(SSQ, row0, rs, fq);
        const float* RT = (const float*)(ws + WS_ROPE);
        if (slot >= nkv + 16) {
            if (wc > 1) return;
            float* GA = (float*)(ws + WS_GATES);
#pragma unroll
            for (int ai = 0; ai < 2; ++ai)
#pragma unroll
                for (int m = 0; m < 4; ++m) { const int row = row0 + ai * 128 + m * 16; const float r = rs[ai][m];
#pragma unroll
                    for (int n = 0; n < 2; ++n) { if (wc == 1 && n == 1) continue; const pg8::f32x4 x = acc[ai][0][m][n] * r;
                        pg8::f32x4 o; o[0] = 1.0f / (1.0f + __expf(-x[0])); o[1] = 1.0f / (1.0f + __expf(-x[1])); o[2] = 1.0f / (1.0f + __expf(-x[2])); o[3] = 1.0f / (1.0f + __expf(-x[3]));
                        *(pg8::f32x4*)(GA + (size_t)row * 48 + 32 * wc + 16 * n + 4 * fq) = o; } }
            return;
        }
        const bool isq = slot >= nkv;
        const int br = slot >> 3, kvsel = (slot >> 2) & 1, g = slot & 3;
        const float* nw = isq ? qnw : (kvsel == 0 && br == 1) ? kns : (kvsel == 0 && br == 2) ? knw : nullptr;
        float nwv[2][2][4];
        if (nw) {
#pragma unroll
            for (int bj = 0; bj < 2; ++bj)
#pragma unroll
                for (int n = 0; n < 2; ++n) { const pg8::f32x4 t = *(const pg8::f32x4*)(nw + 32 * bj + 16 * n + 4 * fq); nwv[bj][n][0] = t[0]; nwv[bj][n][1] = t[1]; nwv[bj][n][2] = t[2]; nwv[bj][n][3] = t[3]; }
        }
        pg8::f32x4 pc01, pc23;
        if (nw) { int sq0, ps0; row_pos(row0, sq0, ps0); pc01 = *(const pg8::f32x4*)(RT + (size_t)ps0 * 16 + 8 * (fq & 1)); pc23 = *(const pg8::f32x4*)(RT + (size_t)ps0 * 16 + 8 * (fq & 1) + 4); }
#pragma unroll
        for (int ai = 0; ai < 2; ++ai)
#pragma unroll
            for (int m = 0; m < 4; ++m) {
                const int row = row0 + ai * 128 + m * 16; const float r = rs[ai][m];
                int seq, pos; row_pos(row, seq, pos);
                const pg8::f32x4 c01 = pc01, c23 = pc23;
                if (nw && (ai * 4 + m) < 7) { const int itn = ai * 4 + m + 1; int sqn, psn; row_pos(row0 + (itn >> 2) * 128 + (itn & 3) * 16, sqn, psn);
                    pc01 = *(const pg8::f32x4*)(RT + (size_t)psn * 16 + 8 * (fq & 1)); pc23 = *(const pg8::f32x4*)(RT + (size_t)psn * 16 + 8 * (fq & 1) + 4); }
                pg8::f32x4 x[2][2];
#pragma unroll
                for (int bj = 0; bj < 2; ++bj)
#pragma unroll
                    for (int n = 0; n < 2; ++n) x[bj][n] = acc[ai][bj][m][n] * r;
                if (nw) {
                    float ss = 0.f;
#pragma unroll
                    for (int bj = 0; bj < 2; ++bj)
#pragma unroll
                        for (int n = 0; n < 2; ++n) ss += (x[bj][n][0] * x[bj][n][0] + x[bj][n][1] * x[bj][n][1]) + (x[bj][n][2] * x[bj][n][2] + x[bj][n][3] * x[bj][n][3]);
                    ss += __shfl_xor(ss, 16); ss += __shfl_xor(ss, 32);
                    const float hr = 1.0f / sqrtf(ss * (1.f / 64) + EPS);
#pragma unroll
                    for (int bj = 0; bj < 2; ++bj)
#pragma unroll
                        for (int n = 0; n < 2; ++n)
#pragma unroll
                            for (int i = 0; i < 4; ++i) x[bj][n][i] = x[bj][n][i] * hr * nwv[bj][n][i];
                }
                if (isq) {
                    bf16* qb = (bf16*)(ws + WS_QNB) + (size_t)row * DM + (slot - nkv) * 64 + 4 * fq;
#pragma unroll
                    for (int bj = 0; bj < 2; ++bj)
#pragma unroll
                        for (int n = 0; n < 2; ++n) { u32x2v w; w.x = pg8::cvt_pk_bf16(x[bj][n][0], x[bj][n][1]); w.y = pg8::cvt_pk_bf16(x[bj][n][2], x[bj][n][3]); *(u32x2v*)(qb + 32 * bj + 16 * n) = w; }
                }
                if (nw) {
                    const float cs[4] = {c01[0], c01[2], c23[0], c23[2]}, sn[4] = {c01[1], c01[3], c23[1], c23[3]};
#pragma unroll
                    for (int i = 0; i < 4; ++i) { const float mine = x[0][0][i], oth = __shfl_xor(mine, 32);
                        x[0][0][i] = (fq < 2) ? mine * cs[i] - oth * sn[i] : mine * cs[i] + oth * sn[i]; }
                }
                float* f1 = nullptr; float* f2 = nullptr; bf16* b1 = nullptr;
                if (isq) b1 = (bf16*)(ws + WS_QRB) + (size_t)row * DM + (slot - nkv) * 64;
                else {
                    const int off = kvsel * 256 + g * 64;
                    if (br == 0) f1 = out + O_KVCMP + (size_t)row * 512 + off;
                    else if (br == 1) { f1 = out + O_KVSLC + (size_t)row * 512 + off; if (row < MP) b1 = (bf16*)(ws + (kvsel ? WS_VSB : WS_KSB)) + (((size_t)seq * 4 + g) * SEQ + pos) * 64; }
                    else { if (row >= MP) f1 = (float*)(ws + WS_KVWIN) + (size_t)row * 512 + off;
                        if (row < MP) { b1 = (bf16*)(ws + (kvsel ? WS_VWB : WS_KWB)) + (((size_t)seq * 4 + g) * SEQ + pos) * 64; if (pos >= SEQ - 512) f2 = out + O_WINP + ((size_t)seq * 512 + (pos - (SEQ - 512))) * 512 + off; }
                        else f2 = out + O_WINS + ((size_t)(seq - 8) * 512 + 508 + (pos - 2048)) * 512 + off; }
                }
#pragma unroll
                for (int bj = 0; bj < 2; ++bj)
#pragma unroll
                    for (int n = 0; n < 2; ++n) { const int d = 32 * bj + 16 * n + 4 * fq;
                        if (f1) *(pg8::f32x4*)(f1 + d) = x[bj][n];
                        if (f2) *(pg8::f32x4*)(f2 + d) = x[bj][n];
                        if (b1) { u32x2v w; w.x = pg8::cvt_pk_bf16(x[bj][n][0], x[bj][n][1]); w.y = pg8::cvt_pk_bf16(x[bj][n][2], x[bj][n][3]); *(u32x2v*)(b1 + d) = w; } }
            }
    }
};

__device__ __forceinline__ void rope_cs(int pos, int i, float& c, float& s) {
    const double inv[8] = {1.0, 0.19392274474868576, 0.03760603093086393, 0.007292664737217109, 0.001414213562373095, 0.0002742481756762073, 5.318295896944988e-05, 1.031338537721246e-05};
    double f = inv[0];
#pragma unroll
    for (int k = 1; k < 8; ++k) f = (i == k) ? inv[k] : f;
    const double ang = (double)pos * f; const double n = __builtin_rint(ang * 0.15915494309189535); const float r = (float)(ang - n * 6.283185307179586);
    c = cosf(r); s = sinf(r);
}
struct WJob { const float* src; const float* src2; const float* gain; const float* gain2; bf16* dst; int Nsrc, Nsrc2, K, Nphys, kind; };
struct WSrc { const float* p; const float* gain; int col, N; };
__device__ __forceinline__ WSrc wmap(const WJob& j, int p) {
    WSrc s; s.p = j.src; s.gain = j.gain; s.N = j.Nsrc; s.col = p;
    if (j.kind == 1) { const int w = p & 7; s.col = (p >> 3) * 4 + (w & 3); if (w >= 4) s.p = j.src2; }
    else if (j.kind == 2 || j.kind == 3) {
        const int ti = p >> 8, q = p & 255, wc = (q & 127) >> 5, d = 32 * (q >> 7) + (q & 31), head = 4 * ti + wc;
        const int nkv = (j.kind == 2) ? 24 : 0;
        if (head < nkv) { s.col = 64 * head + d; }
        else if (head < nkv + 16) { s.col = 64 * (head - nkv) + d; if (j.kind == 2) { s.p = j.src2; s.gain = j.gain2; s.N = j.Nsrc2; } }
        else { if (j.kind == 2) { s.p = j.src2; s.gain = j.gain2; s.N = j.Nsrc2; } s.col = (q < 48) ? 1024 + q : -1; }
    }
    return s;
}
__device__ __forceinline__ void conv_item(const WJob& j, int item, LAS float* scr, int lane) {
    const int nblk = j.Nphys / 32, kb = item / nblk, nb = item % nblk, k0 = 64 * kb, p0 = 32 * nb;
    const int p4 = (lane & 7) * 4, kr = lane >> 3;
    const WSrc s = wmap(j, p0 + p4);
#pragma unroll
    for (int i = 0; i < 8; ++i) { const int kk = 8 * i + kr; f32x4 v = (f32x4){0.f, 0.f, 0.f, 0.f};
        if (s.col >= 0) { v = __builtin_nontemporal_load((const f32x4*)(s.p + (size_t)(k0 + kk) * s.N + s.col)); if (s.gain) v = v * s.gain[k0 + kk]; }
        LAS float* d = scr + kk * 33 + p4; d[0] = v.x; d[1] = v.y; d[2] = v.z; d[3] = v.w; }
    asm volatile("s_waitcnt lgkmcnt(0)" ::: "memory");
    const int c = lane & 7;
#pragma unroll
    for (int jj = 0; jj < 4; ++jj) { const int n = (lane >> 3) + 8 * jj; const LAS float* sp = scr + (8 * c) * 33 + n;
        v4u o; o.x = pk2(sp[0 * 33], sp[1 * 33]); o.y = pk2(sp[2 * 33], sp[3 * 33]); o.z = pk2(sp[4 * 33], sp[5 * 33]); o.w = pk2(sp[6 * 33], sp[7 * 33]);
        if (j.kind == 4) {
            const int e2 = j.Nsrc2 * 64 + p0 + n, k = k0 + 8 * c, ll = k >> 6, hh = (k >> 5) & 1, sx = (k >> 3) & 3;
            *(GAS v4u*)(j.dst + ((size_t)(((ll * 4 + sx) * 4 + (e2 >> 5)) * 64 + hh * 32 + (e2 & 31))) * 8) = o;
        } else
        *(GAS v4u*)(j.dst + (size_t)(p0 + n) * j.K + k0 + 8 * c) = o; }
    asm volatile("s_waitcnt lgkmcnt(0)" ::: "memory");
}
constexpr int NJOBS = 20;
__device__ __forceinline__ WJob get_job(const Args& a, int j) {
    const float* const* in = (const float* const*)a.in; unsigned char* ws = a.ws;
    WJob w; w.src2 = nullptr; w.gain = nullptr; w.gain2 = nullptr; w.Nsrc2 = 0; w.kind = 0;
    if (j < 2)       { const int l = j;      w.src = in[I_AWIN] + (size_t)l * DM * 4096; w.gain = in[I_NMIX] + l * DM; w.dst = (bf16*)(ws + WS_WIN) + (size_t)l * 4096 * DM; w.Nsrc = 4096; w.K = DM; w.Nphys = 4096; }
    else if (j < 4)  { const int l = j - 2;  w.src = in[I_AWOUT] + (size_t)l * DA * DM; w.dst = (bf16*)(ws + WS_WOUTA) + (size_t)l * DM * DA; w.Nsrc = DM; w.K = DA; w.Nphys = DM; }
    else if (j < 8)  { const int l = j - 4;  w.src = in[I_WG] + (size_t)l * DM * DFF; w.src2 = in[I_WU] + (size_t)l * DM * DFF; w.gain = in[I_NFFN] + l * DM; w.dst = (bf16*)(ws + WS_WGU) + (size_t)l * 2 * DFF * DM; w.Nsrc = DFF; w.K = DM; w.Nphys = 2 * DFF; w.kind = 1; }
    else if (j < 12) { const int l = j - 8;  w.src = in[I_WD] + (size_t)l * DFF * DM; w.dst = (bf16*)(ws + WS_WD) + (size_t)l * DM * DFF; w.Nsrc = DM; w.K = DFF; w.Nphys = DM; }
    else if (j == 12) { w.src = in[I_KVW]; w.gain = in[I_KVN]; w.Nsrc = 1536; w.src2 = in[I_BWIN]; w.gain2 = in[I_NMIX] + 2 * DM; w.Nsrc2 = 1072; w.dst = (bf16*)(ws + WS_WKVQ); w.K = DM; w.Nphys = NKVQ; w.kind = 2; }
    else if (j == 13) { w.src = in[I_BWIN] + (size_t)DM * 1072; w.gain = in[I_NMIX] + 3 * DM; w.Nsrc = 1072; w.dst = (bf16*)(ws + WS_WQ3); w.K = DM; w.Nphys = NQ3; w.kind = 3; }
    else if (j < 16) { const int l = j - 14; w.src = in[I_BWOUT] + (size_t)l * DM * DM; w.dst = (bf16*)(ws + WS_WOB) + (size_t)l * DM * DM; w.Nsrc = DM; w.K = DM; w.Nphys = DM; }
    else { const int kv = (j - 16) >> 1, half = (j - 16) & 1; w.src = in[kv ? I_CWV : I_CWK] + (size_t)half * 1024 * 64; w.dst = (bf16*)(ws + WS_CWT) + (size_t)kv * 128 * 1024; w.Nsrc = 64; w.Nsrc2 = half; w.K = 1024; w.Nphys = 64; w.kind = 4; }
    return w;
}
__device__ __forceinline__ int job_items(int j) { return j < 2 ? 2048 : j < 4 ? 1024 : j < 8 ? 2816 : j < 13 ? 1408 : j == 13 ? 640 : j < 16 ? 512 : 32; }
__device__ __forceinline__ bool conv_locate(const Args& a, int g, WJob& w, int& it) {
    int j = 0;
    for (; j < NJOBS; ++j) { const int n = job_items(j); if (g < n) break; g -= n; }
    if (j >= NJOBS) return false;
    w = get_job(a, j); it = g; return true;
}
__device__ __forceinline__ void conv_load(const WJob& j, int item, int lane, f32x4 (&v)[8], float (&gn)[8]) {
    const int nblk = j.Nphys / 32, kb = item / nblk, nb = item % nblk, k0 = 64 * kb, p0 = 32 * nb;
    const int p4 = (lane & 7) * 4, kr = lane >> 3;
    const WSrc s = wmap(j, p0 + p4);
#pragma unroll
    for (int i = 0; i < 8; ++i) { const int kk = 8 * i + kr; v[i] = (f32x4){0.f, 0.f, 0.f, 0.f}; gn[i] = 1.f;
        if (s.col >= 0) { v[i] = __builtin_nontemporal_load((const f32x4*)(s.p + (size_t)(k0 + kk) * s.N + s.col)); if (s.gain) gn[i] = s.gain[k0 + kk]; } }
}
__device__ __forceinline__ void conv_store(const WJob& j, int item, int lane, LAS float* scr, const f32x4 (&v)[8], const float (&gn)[8]) {
    const int nblk = j.Nphys / 32, kb = item / nblk, nb = item % nblk, k0 = 64 * kb, p0 = 32 * nb;
    const int p4 = (lane & 7) * 4, kr = lane >> 3;
#pragma unroll
    for (int i = 0; i < 8; ++i) { const int kk = 8 * i + kr; const f32x4 x = v[i] * gn[i];
        LAS float* d = scr + kk * 33 + p4; d[0] = x.x; d[1] = x.y; d[2] = x.z; d[3] = x.w; }
    asm volatile("s_waitcnt lgkmcnt(0)" ::: "memory");
    const int c = lane & 7;
#pragma unroll
    for (int jj = 0; jj < 4; ++jj) { const int n = (lane >> 3) + 8 * jj; const LAS float* sp = scr + (8 * c) * 33 + n;
        v4u o; o.x = pk2(sp[0 * 33], sp[1 * 33]); o.y = pk2(sp[2 * 33], sp[3 * 33]); o.z = pk2(sp[4 * 33], sp[5 * 33]); o.w = pk2(sp[6 * 33], sp[7 * 33]);
        if (j.kind == 4) {
            const int e2 = j.Nsrc2 * 64 + p0 + n, k = k0 + 8 * c, ll = k >> 6, hh = (k >> 5) & 1, sx = (k >> 3) & 3;
            *(GAS v4u*)(j.dst + ((size_t)(((ll * 4 + sx) * 4 + (e2 >> 5)) * 64 + hh * 32 + (e2 & 31))) * 8) = o;
        } else
        *(GAS v4u*)(j.dst + (size_t)(p0 + n) * j.K + k0 + 8 * c) = o; }
    asm volatile("s_waitcnt lgkmcnt(0)" ::: "memory");
}
__device__ __forceinline__ void phase_prologue(const Frame& F, const Args& a) {
    LAS float* scr = (LAS float*)(F.lds + F.wave * 16384);
    const int gw = F.vcu * NWAVES + F.wave, NGW = F.G * NWAVES;
    {
        int g = gw; WJob wa, wb; int ia = 0, ib = 0; f32x4 A[8], B[8]; float ga[8], gb[8];
        bool va = conv_locate(a, g, wa, ia), vb = false;
        if (va) conv_load(wa, ia, F.lane, A, ga);
        while (va) {
            g += NGW; vb = conv_locate(a, g, wb, ib);
            if (vb) conv_load(wb, ib, F.lane, B, gb);
            __builtin_amdgcn_sched_barrier(0);
            conv_store(wa, ia, F.lane, scr, A, ga);
            if (!vb) break;
            g += NGW; va = conv_locate(a, g, wa, ia);
            if (va) conv_load(wa, ia, F.lane, A, ga);
            __builtin_amdgcn_sched_barrier(0);
            conv_store(wb, ib, F.lane, scr, B, gb);
        }
    }
    for (int i = F.vcu * NTHR + F.tid; i < 2052 * 8; i += F.G * NTHR) { float c, sn; rope_cs(i >> 3, i & 7, c, sn); ((float*)(a.ws + WS_ROPE))[2 * i] = c; ((float*)(a.ws + WS_ROPE))[2 * i + 1] = sn; }
    for (int o = gw; o < 128; o += NGW) { const int kv = o >> 6, e = o & 63; const float* pw = (const float*)a.in[kv ? I_CPV : I_CPK]; const float* ww = (const float*)a.in[kv ? I_CWV : I_CWK];
        float acc = 0.f; for (int i = F.lane; i < 2048; i += 64) acc += pw[i] * ww[(size_t)i * 64 + e];
        acc = wave_sum(acc); if (F.lane == 0) ((float*)(a.ws + WS_CBIAS))[o] = acc; }
    for (int m = gw; m < M; m += 2 * NGW) {
        const int m2 = (m + NGW < M) ? m + NGW : m;
        const f32x4* xr = (const f32x4*)((m < MP) ? (const float*)a.in[I_XP] + (size_t)m * DM : (const float*)a.in[I_XS] + (size_t)(m - MP) * DM) + F.lane;
        const f32x4* xq = (const f32x4*)((m2 < MP) ? (const float*)a.in[I_XP] + (size_t)m2 * DM : (const float*)a.in[I_XS] + (size_t)(m2 - MP) * DM) + F.lane;
        f32x4 v[4], w[4];
#pragma unroll
        for (int j = 0; j < 4; ++j) v[j] = __builtin_nontemporal_load(xr + 64 * j);
#pragma unroll
        for (int j = 0; j < 4; ++j) w[j] = __builtin_nontemporal_load(xq + 64 * j);
        __builtin_amdgcn_sched_barrier(0);
        {   unsigned long long* o8 = (unsigned long long*)((bf16*)(a.ws + WS_XN) + (size_t)m * DM) + F.lane;
            float ss = 0.f;
#pragma unroll
            for (int j = 0; j < 4; ++j) { ss += (v[j].x * v[j].x + v[j].y * v[j].y) + (v[j].z * v[j].z + v[j].w * v[j].w);
                o8[64 * j] = (unsigned long long)pk2(v[j].x, v[j].y) | ((unsigned long long)pk2(v[j].z, v[j].w) << 32); }
            ss = wave_sum(ss);
            if (F.lane < 16) ((float*)(a.ws + WS_SSQB))[(size_t)m * 16 + F.lane] = (F.lane == 0) ? ss : 0.f; }
        if (m2 != m) {
            unsigned long long* o8 = (unsigned long long*)((bf16*)(a.ws + WS_XN) + (size_t)m2 * DM) + F.lane;
            float ss = 0.f;
#pragma unroll
            for (int j = 0; j < 4; ++j) { ss += (w[j].x * w[j].x + w[j].y * w[j].y) + (w[j].z * w[j].z + w[j].w * w[j].w);
                o8[64 * j] = (unsigned long long)pk2(w[j].x, w[j].y) | ((unsigned long long)pk2(w[j].z, w[j].w) << 32); }
            ss = wave_sum(ss);
            if (F.lane < 16) ((float*)(a.ws + WS_SSQB))[(size_t)m2 * 16 + F.lane] = (F.lane == 0) ? ss : 0.f; }
    }
    const int gt = F.vcu * NTHR + F.tid, NGT = F.G * NTHR;
}

__device__ __forceinline__ void phase_norm(const Frame& F, const float* H, bf16* XN) {
    const int gw = F.vcu * NWAVES + F.wave, NGW = F.G * NWAVES;
    for (int m = gw; m < M; m += NGW) {
        const f32x4* xr = (const f32x4*)(H + (size_t)m * DM) + F.lane;
        f32x4 v[4]; float s = 0.f;
#pragma unroll
        for (int j = 0; j < 4; ++j) { v[j] = xr[64 * j]; s += (v[j].x * v[j].x + v[j].y * v[j].y) + (v[j].z * v[j].z + v[j].w * v[j].w); }
        const float rstd = 1.0f / sqrtf(wave_sum(s) * (1.f / DM) + EPS);
        unsigned long long* o8 = (unsigned long long*)(XN + (size_t)m * DM) + F.lane;
#pragma unroll
        for (int j = 0; j < 4; ++j) o8[64 * j] = (unsigned long long)pk2(v[j].x * rstd, v[j].y * rstd) | ((unsigned long long)pk2(v[j].z * rstd, v[j].w * rstd) << 32);
    }
}
__device__ __forceinline__ void phase_lnstat(const Frame& F, const bf16* UV, float* LNST) {
    const int gw = F.vcu * NWAVES + F.wave, NGW = F.G * NWAVES;
    for (int m = gw; m < M; m += NGW) {
        const v4u* vr = (const v4u*)(UV + (size_t)m * 4096 + 2048) + F.lane;
        float x[32]; float s = 0.f;
#pragma unroll
        for (int j = 0; j < 4; ++j) { const v4u w = vr[64 * j];
#pragma unroll
            for (int e = 0; e < 4; ++e) { const unsigned ww = w[e]; x[8 * j + 2 * e] = __builtin_bit_cast(float, ww << 16); x[8 * j + 2 * e + 1] = __builtin_bit_cast(float, ww & 0xffff0000u); } }
#pragma unroll
        for (int i = 0; i < 32; ++i) s += x[i];
        const float mean = wave_sum(s) * (1.f / DA); float q = 0.f;
#pragma unroll
        for (int i = 0; i < 32; ++i) { const float d = x[i] - mean; q += d * d; }
        const float rstd = 1.0f / sqrtf(wave_sum(q) * (1.f / DA) + EPS);
        if (F.lane == 0) { LNST[2 * m] = mean; LNST[2 * m + 1] = rstd; }
    }
}
__device__ __forceinline__ void phase_spatial_naive(const Frame& F, const Args& a, int l, const int rlo) {
    const bf16* UV = (const bf16*)(a.ws + WS_UV); const float* LNST = (const float*)(a.ws + WS_LNST); bf16* GT = (bf16*)(a.ws + WS_GATED);
    const float* lng = (const float*)a.in[I_ALNG] + l * DA; const float* lnb = (const float*)a.in[I_ALNB] + l * DA;
    const float* ws = (const float*)a.in[I_AWS] + (size_t)l * 8 * 128 * 128; const float* bs = (const float*)a.in[I_ABS] + l * 8 * 128;
    float* av = a.out + O_AV + (size_t)l * 128 * 4 * DA;
    const int gt = F.vcu * NTHR + F.tid, NGT = F.G * NTHR;
    for (size_t it = (size_t)rlo * 256 + gt; it < (size_t)M * 256; it += NGT) {
        const int row = (int)(it >> 8), c = (int)(it & 255) * 8, g = c >> 8;
        const int tt = (row < MP) ? (row & 127) : ((row - MP) & 3), r0 = row - tt;
        float gg[8], bb[8], acc[8];
#pragma unroll
        for (int i = 0; i < 8; ++i) { gg[i] = lng[c + i]; bb[i] = lnb[c + i]; acc[i] = 0.f; }
        const float* wrow = ws + ((size_t)g * 128 + tt) * 128;
        float own[8];
        for (int s = 0; s <= tt; ++s) {
            const float w = wrow[s], mean = LNST[2 * (r0 + s)], rstd = LNST[2 * (r0 + s) + 1];
            const v4u vv = *(const v4u*)(UV + (size_t)(r0 + s) * 4096 + 2048 + c);
#pragma unroll
            for (int e = 0; e < 4; ++e) { const unsigned ww = vv[e];
                const float v0 = (__builtin_bit_cast(float, ww << 16) - mean) * rstd * gg[2 * e] + bb[2 * e];
                const float v1 = (__builtin_bit_cast(float, ww & 0xffff0000u) - mean) * rstd * gg[2 * e + 1] + bb[2 * e + 1];
                acc[2 * e] += w * v0; acc[2 * e + 1] += w * v1; own[2 * e] = v0; own[2 * e + 1] = v1; }
        }
        const float bst = bs[g * 128 + tt];
        const v4u uu = *(const v4u*)(UV + (size_t)row * 4096 + c);
        v4u o;
#pragma unroll
        for (int e = 0; e < 4; ++e) { const unsigned ww = uu[e];
            o[e] = pk2(__builtin_bit_cast(float, ww << 16) * (acc[2 * e] + bst), __builtin_bit_cast(float, ww & 0xffff0000u) * (acc[2 * e + 1] + bst)); }
        *(v4u*)(GT + (size_t)row * DA + c) = o;
        if (row >= MP) { float* ap = av + (size_t)(row - MP) * DA + c; *(f32x4*)ap = (f32x4){own[0], own[1], own[2], own[3]}; *(f32x4*)(ap + 4) = (f32x4){own[4], own[5], own[6], own[7]}; }
    }
}

__device__ __forceinline__ void phase_post_naive(const Frame& F, const Args& a, int l) {
    const int ldp = (l == 2) ? NKVQ : NQ3, nkv = (l == 2) ? 24 : 0, nslot = nkv + 17;
    const float* P = (const float*)(a.ws + WS_PROJ);
    float* QN = (float*)(a.ws + WS_QN); float* QR = (float*)(a.ws + WS_QR); float* GA = (float*)(a.ws + WS_GATES); float* KVW = (float*)(a.ws + WS_KVWIN);
    const float* qnw = (const float*)a.in[I_BQN] + (l - 2) * 64;
    const int gt = F.vcu * NTHR + F.tid, NGT = F.G * NTHR;
    for (size_t it = gt; it < (size_t)M * nslot; it += NGT) {
        const int row = (int)(it / nslot), slot = (int)(it % nslot);
        int seq, pos; row_pos(row, seq, pos);
        const float* pr = P + (size_t)row * ldp;
        if (slot == nkv + 16) {
            const float* gp = pr + (nkv / 4 + 4) * 256;
            for (int i = 0; i < 48; ++i) GA[(size_t)row * 48 + i] = 1.0f / (1.0f + expf(-gp[i]));
            continue;
        }
        const int ti = slot >> 2, wc = slot & 3;
        float x[64];
#pragma unroll
        for (int i = 0; i < 16; ++i) { const int d = 4 * i; const f32x4 v = *(const f32x4*)(pr + ti * 256 + 128 * (d >> 5) + 32 * wc + (d & 31)); x[d] = v.x; x[d + 1] = v.y; x[d + 2] = v.z; x[d + 3] = v.w; }
        const float* nw = nullptr; bool do_rope = false; float* dst = nullptr; float* dst2 = nullptr; float* dst3 = nullptr; bf16* bdst = nullptr;
        if (slot < nkv) {
            const int br = slot >> 3, kvsel = (slot >> 2) & 1, g = slot & 3; const int off = kvsel * 256 + g * 64;
            if (br >= 1 && row < MP) bdst = (bf16*)(a.ws + (br == 1 ? (kvsel ? WS_VSB : WS_KSB) : (kvsel ? WS_VWB : WS_KWB))) + (((size_t)seq * 4 + g) * SEQ + pos) * 64;
            if (br == 0) dst = a.out + O_KVCMP + (size_t)row * 512 + off;
            else if (br == 1) { dst = a.out + O_KVSLC + (size_t)row * 512 + off; if (!kvsel) { nw = (const float*)a.in[I_KNS]; do_rope = true; } }
            else { dst = KVW + (size_t)row * 512 + off; if (!kvsel) { nw = (const float*)a.in[I_KNW]; do_rope = true; }
                if (row < MP) { if (pos >= SEQ - 512) dst2 = a.out + O_WINP + ((size_t)seq * 512 + (pos - (SEQ - 512))) * 512 + off; }
                else dst2 = a.out + O_WINS + ((size_t)(seq - 8) * 512 + 508 + (pos - 2048)) * 512 + off; }
        } else { const int h = slot - nkv; nw = qnw; dst = QN + (size_t)row * DM + h * 64; dst3 = QR + (size_t)row * DM + h * 64; do_rope = true; }
        if (nw) { float ss = 0.f;
#pragma unroll
            for (int d = 0; d < 64; ++d) ss += x[d] * x[d];
            const float rs = 1.0f / sqrtf(ss * (1.f / 64) + EPS);
#pragma unroll
            for (int d = 0; d < 64; ++d) x[d] = x[d] * rs * nw[d]; }
        if (dst3) {
#pragma unroll
            for (int i = 0; i < 16; ++i) *(f32x4*)(dst + 4 * i) = (f32x4){x[4 * i], x[4 * i + 1], x[4 * i + 2], x[4 * i + 3]};
            bf16* qb = (bf16*)(a.ws + WS_QNB) + (size_t)row * DM + (slot - nkv) * 64;
#pragma unroll
            for (int i = 0; i < 8; ++i) { v4u w; w.x = pk2(x[8 * i], x[8 * i + 1]); w.y = pk2(x[8 * i + 2], x[8 * i + 3]); w.z = pk2(x[8 * i + 4], x[8 * i + 5]); w.w = pk2(x[8 * i + 6], x[8 * i + 7]); *(v4u*)(qb + 8 * i) = w; }
            dst = dst3; bdst = (bf16*)(a.ws + WS_QRB) + (size_t)row * DM + (slot - nkv) * 64;
        }
        if (do_rope) {
#pragma unroll
            for (int i = 0; i < 8; ++i) { float c, s; rope_cs(pos, i, c, s); const float x1 = x[i], x2 = x[8 + i]; x[i] = x1 * c - x2 * s; x[8 + i] = x2 * c + x1 * s; }
        }
#pragma unroll
        for (int i = 0; i < 16; ++i) { const f32x4 v = (f32x4){x[4 * i], x[4 * i + 1], x[4 * i + 2], x[4 * i + 3]}; *(f32x4*)(dst + 4 * i) = v; if (dst2) *(f32x4*)(dst2 + 4 * i) = v; }
        if (bdst) {
#pragma unroll
            for (int i = 0; i < 8; ++i) { v4u w; w.x = pk2(x[8 * i], x[8 * i + 1]); w.y = pk2(x[8 * i + 2], x[8 * i + 3]); w.z = pk2(x[8 * i + 4], x[8 * i + 5]); w.w = pk2(x[8 * i + 6], x[8 * i + 7]); *(v4u*)(bdst + 8 * i) = w; }
        }
    }
}
__device__ __forceinline__ void phase_compress_naive(const Frame& F, const Args& a) {
    const int gw = F.vcu * NWAVES + F.wave, NGW = F.G * NWAVES, e = F.lane;
    const int* pt = (const int*)a.in[I_PT]; const float* cc = (const float*)a.in[I_CCMP];
    const float* knc = (const float*)a.in[I_KNC];
    for (int it = gw; it < 136 * 127 * 4 * 2; it += NGW) {
        const int which = it & 1, g = (it >> 1) & 3, n = (it >> 3) % 127, seq = (it >> 3) / 127;
        const float* w = (const float*)a.in[which ? I_CWV : I_CWK]; const float* posw = (const float*)a.in[which ? I_CPV : I_CPK];
        float acc = 0.f;
        for (int ll = 0; ll < 32; ++ll) {
            const int r = 16 * n + ll; const float* rp;
            if (seq < 8) rp = a.out + O_KVCMP + ((size_t)seq * SEQ + r) * 512;
            else rp = cc + ((size_t)pt[(seq - 8) * 16 + (r >> 7)] * 128 + (r & 127)) * 512;
            const float x = rp[which * 256 + g * 64 + e] + posw[ll * 64 + e];
            const float* wl = w + (size_t)ll * 4096 + e;
#pragma unroll
            for (int d = 0; d < 64; ++d) acc += __builtin_bit_cast(float, __builtin_amdgcn_readlane(__builtin_bit_cast(int, x), d)) * wl[d * 64];
        }
        float* dst = (float*)(a.ws + (which ? WS_VC : WS_KC)) + (((size_t)seq * 127 + n) * 4 + g) * 64;
        if (!which) { const float ss = wave_sum(acc * acc); acc = acc * (1.0f / sqrtf(ss * (1.f / 64) + EPS)) * knc[e]; }
        dst[e] = acc;
        bf16* bd = (bf16*)(a.ws + (which ? WS_VCB : WS_KCB)) + (((size_t)seq * 4 + g) * 128 + n) * 64;
        bd[e] = (bf16)f2bf(acc);
        if (n == 126) bd[64 + e] = 0;
    }
}
__device__ __forceinline__ void load64(const float* p, float (&q)[64]) {
#pragma unroll
    for (int i = 0; i < 16; ++i) { const f32x4 v = *(const f32x4*)(p + 4 * i); q[4 * i] = v.x; q[4 * i + 1] = v.y; q[4 * i + 2] = v.z; q[4 * i + 3] = v.w; }
}
__device__ __forceinline__ float dot64(const float (&q)[64], const float* k) {
    float s0 = 0.f, s1 = 0.f, s2 = 0.f, s3 = 0.f;
#pragma unroll
    for (int i = 0; i < 16; ++i) { const f32x4 v = *(const f32x4*)(k + 4 * i); s0 += q[4 * i] * v.x; s1 += q[4 * i + 1] * v.y; s2 += q[4 * i + 2] * v.z; s3 += q[4 * i + 3] * v.w; }
    return (s0 + s1) + (s2 + s3);
}
__device__ __forceinline__ void axpy64(float (&o)[64], float p, const float* v) {
#pragma unroll
    for (int i = 0; i < 16; ++i) { const f32x4 x = *(const f32x4*)(v + 4 * i); o[4 * i] += p * x.x; o[4 * i + 1] += p * x.y; o[4 * i + 2] += p * x.z; o[4 * i + 3] += p * x.w; }
}
__device__ __forceinline__ void phase_acmp_naive(const Frame& F, const Args& a, const int rlo) {
    const float* QN = (const float*)(a.ws + WS_QN); const float* KC = (const float*)(a.ws + WS_KC); const float* VC = (const float*)(a.ws + WS_VC);
    float* PC = (float*)(a.ws + WS_PCMP); float* OC = (float*)(a.ws + WS_OC);
    const int gt = F.vcu * NTHR + F.tid, NGT = F.G * NTHR;
    for (size_t it = (size_t)rlo * 16 + gt; it < (size_t)M * 16; it += NGT) {
        const int row = (int)(it >> 4), head = (int)(it & 15), g = head >> 2;
        int seq, pos; row_pos(row, seq, pos);
        float q[64]; load64(QN + (size_t)row * DM + head * 64, q);
        float* pc = PC + ((size_t)row * 16 + head) * 128;
        const int nv = (pos >= 31) ? min(127, (pos - 31) / 16 + 1) : 0;
        float m = -INFINITY;
        for (int n = 0; n < nv; ++n) { const float s = dot64(q, KC + (((size_t)seq * 127 + n) * 4 + g) * 64) * 0.125f; pc[n] = s; m = fmaxf(m, s); }
        float lsum = 0.f;
        for (int n = 0; n < nv; ++n) lsum += expf(pc[n] - m);
        const float inv = 1.0f / fmaxf(lsum, 1e-30f);
        float o[64];
#pragma unroll
        for (int d = 0; d < 64; ++d) o[d] = 0.f;
        for (int n = 0; n < nv; ++n) { const float p = expf(pc[n] - m) * inv; pc[n] = p; axpy64(o, p, VC + (((size_t)seq * 127 + n) * 4 + g) * 64); }
        for (int n = nv; n < 128; ++n) pc[n] = 0.f;
        float* op = OC + (size_t)row * DM + head * 64;
#pragma unroll
        for (int i = 0; i < 16; ++i) *(f32x4*)(op + 4 * i) = (f32x4){o[4 * i], o[4 * i + 1], o[4 * i + 2], o[4 * i + 3]};
    }
}
__device__ __forceinline__ void phase_asel_naive(const Frame& F, const Args& a, const int rlo) {
    const float* PC = (const float*)(a.ws + WS_PCMP); float* SC = (float*)(a.ws + WS_SCORE); unsigned long long* SM = (unsigned long long*)(a.ws + WS_SELM);
    const int gt = F.vcu * NTHR + F.tid, NGT = F.G * NTHR;
    for (size_t it = (size_t)rlo * 4 + gt; it < (size_t)M * 4; it += NGT) {
        const int row = (int)(it >> 2), g = (int)(it & 3);
        int seq, pos; row_pos(row, seq, pos);
        const int nsel = (row < MP) ? 32 : 33, cur = pos >> 6;
        float* sc = SC + (size_t)it * 40;
        const float* pc = PC + ((size_t)row * 16 + g * 4) * 128;
        for (int j = 0; j < nsel; ++j) {
            float imp = 0.f;
            for (int n = max(0, 4 * j - 1); n <= min(126, 4 * j + 3); ++n) imp += (pc[n] + pc[128 + n]) + (pc[256 + n] + pc[384 + n]);
            const bool forced = (j == 0) || (j == cur) || (j == cur - 1), valid = j <= cur;
            sc[j] = forced ? INFINITY : (valid ? imp : -INFINITY);
        }
        unsigned long long mask = 0ull;
        for (int j = 0; j < nsel; ++j) { const float sj = sc[j]; int rank = 0;
            for (int i = 0; i < nsel; ++i) { const float si = sc[i]; rank += (si > sj || (si == sj && i < j)) ? 1 : 0; }
            if (rank < 16 && sj > -INFINITY) mask |= 1ull << j; }
        SM[it] = mask;
    }
}
__device__ __forceinline__ void phase_aslc_naive(const Frame& F, const Args& a, const int rlo) {
    const float* QR = (const float*)(a.ws + WS_QR); const unsigned long long* SM = (const unsigned long long*)(a.ws + WS_SELM); float* OS = (float*)(a.ws + WS_OS);
    const float* KVS = a.out + O_KVSLC; const float* cs = (const float*)a.in[I_CSLC]; const int* pt = (const int*)a.in[I_PT];
    const int gt = F.vcu * NTHR + F.tid, NGT = F.G * NTHR;
    for (size_t it = (size_t)rlo * 16 + gt; it < (size_t)M * 16; it += NGT) {
        const int row = (int)(it >> 4), head = (int)(it & 15), g = head >> 2;
        int seq, pos; row_pos(row, seq, pos);
        float q[64]; load64(QR + (size_t)row * DM + head * 64, q);
        const unsigned long long mask = SM[(size_t)row * 4 + g];
        const int nsel = (row < MP) ? 32 : 33;
        float m = -INFINITY, lsum = 0.f, o[64];
#pragma unroll
        for (int d = 0; d < 64; ++d) o[d] = 0.f;
        for (int j = 0; j < nsel; ++j) {
            if (!((mask >> j) & 1ull)) continue;
            for (int kk = 0; kk < 64; ++kk) {
                const int key = 64 * j + kk; if (key > pos) break;
                const float* kp;
                if (row < MP) kp = KVS + ((size_t)seq * SEQ + key) * 512 + g * 64;
                else if (key < 2048) kp = cs + ((size_t)pt[(seq - 8) * 16 + (key >> 7)] * 128 + (key & 127)) * 512 + g * 64;
                else kp = KVS + ((size_t)MP + (seq - 8) * 4 + (key - 2048)) * 512 + g * 64;
                const float s = dot64(q, kp) * 0.125f;
                if (s > m) { const float f = expf(m - s); lsum *= f;
#pragma unroll
                    for (int d = 0; d < 64; ++d) o[d] *= f;
                    m = s; }
                const float p = expf(s - m); lsum += p; axpy64(o, p, kp + 256);
            }
        }
        const float inv = 1.0f / fmaxf(lsum, 1e-30f);
        float* op = OS + (size_t)row * DM + head * 64;
#pragma unroll
        for (int i = 0; i < 16; ++i) *(f32x4*)(op + 4 * i) = (f32x4){o[4 * i] * inv, o[4 * i + 1] * inv, o[4 * i + 2] * inv, o[4 * i + 3] * inv};
    }
}
__device__ __forceinline__ void phase_awin_naive(const Frame& F, const Args& a, const int rlo) {
    const float* QR = (const float*)(a.ws + WS_QR); const float* OC = (const float*)(a.ws + WS_OC); const float* OS = (const float*)(a.ws + WS_OS);
    const float* GA = (const float*)(a.ws + WS_GATES); const float* KVW = (const float*)(a.ws + WS_KVWIN); const float* sw = (const float*)a.in[I_SWIN];
    bf16* O = (bf16*)(a.ws + WS_O);
    const int gt = F.vcu * NTHR + F.tid, NGT = F.G * NTHR;
    for (size_t it = (size_t)rlo * 16 + gt; it < (size_t)M * 16; it += NGT) {
        const int row = (int)(it >> 4), head = (int)(it & 15), g = head >> 2;
        int seq, pos; row_pos(row, seq, pos);
        float q[64]; load64(QR + (size_t)row * DM + head * 64, q);
        float m = -INFINITY, lsum = 0.f, o[64];
#pragma unroll
        for (int d = 0; d < 64; ++d) o[d] = 0.f;
        for (int key = max(0, pos - 511); key <= pos; ++key) {
            const float* kp;
            if (row < MP) kp = KVW + ((size_t)seq * SEQ + key) * 512 + g * 64;
            else if (key < 2048) kp = sw + ((size_t)(seq - 8) * 512 + (key - 1536)) * 512 + g * 64;
            else kp = KVW + ((size_t)MP + (seq - 8) * 4 + (key - 2048)) * 512 + g * 64;
            const float s = dot64(q, kp) * 0.125f;
            if (s > m) { const float f = expf(m - s); lsum *= f;
#pragma unroll
                for (int d = 0; d < 64; ++d) o[d] *= f;
                m = s; }
            const float p = expf(s - m); lsum += p; axpy64(o, p, kp + 256);
        }
        const float inv = 1.0f / fmaxf(lsum, 1e-30f);
        const float g0 = GA[(size_t)row * 48 + head * 3], g1 = GA[(size_t)row * 48 + head * 3 + 1], g2 = GA[(size_t)row * 48 + head * 3 + 2] * inv;
        const float* oc = OC + (size_t)row * DM + head * 64; const float* os = OS + (size_t)row * DM + head * 64;
        bf16* op = O + (size_t)row * DM + head * 64;
#pragma unroll
        for (int i = 0; i < 8; ++i) { const f32x4 c0 = *(const f32x4*)(oc + 8 * i), c1 = *(const f32x4*)(oc + 8 * i + 4), s0 = *(const f32x4*)(os + 8 * i), s1 = *(const f32x4*)(os + 8 * i + 4);
            v4u w;
            w.x = pk2(g0 * c0.x + g1 * s0.x + g2 * o[8 * i], g0 * c0.y + g1 * s0.y + g2 * o[8 * i + 1]);
            w.y = pk2(g0 * c0.z + g1 * s0.z + g2 * o[8 * i + 2], g0 * c0.w + g1 * s0.w + g2 * o[8 * i + 3]);
            w.z = pk2(g0 * c1.x + g1 * s1.x + g2 * o[8 * i + 4], g0 * c1.y + g1 * s1.y + g2 * o[8 * i + 5]);
            w.w = pk2(g0 * c1.z + g1 * s1.z + g2 * o[8 * i + 6], g0 * c1.w + g1 * s1.w + g2 * o[8 * i + 7]);
            *(v4u*)(op + 8 * i) = w; }
    }
}


namespace fa {
typedef short bf16x8 __attribute__((ext_vector_type(8)));
typedef short s16x4 __attribute__((ext_vector_type(4)));
typedef float f32x16 __attribute__((ext_vector_type(16)));
typedef LAS const char* lcp;
constexpr float C2 = 0.125f * 1.4426950408889634f;
__device__ __forceinline__ int crow(int r, int hi) { return (r & 3) + 8 * (r >> 2) + 4 * hi; }
__device__ __forceinline__ s16x4 vtr(lcp p) { return __builtin_bit_cast(s16x4, __builtin_amdgcn_ds_read_tr16_b64_v4i16((LAS s16x4*)p)); }
__device__ __forceinline__ float max3f(float a, float b, float c) { return __builtin_fmaxf(__builtin_fmaxf(a, b), c); }
__device__ __forceinline__ float swapmax(float m) { auto rr = __builtin_amdgcn_permlane32_swap(__float_as_uint(m), __float_as_uint(m), false, false); return fmaxf(__uint_as_float(rr[0]), __uint_as_float(rr[1])); }
__device__ __forceinline__ float swapsum(float m) { auto rr = __builtin_amdgcn_permlane32_swap(__float_as_uint(m), __float_as_uint(m), false, false); return __uint_as_float(rr[0]) + __uint_as_float(rr[1]); }
struct St { f32x16 o0, o1; float m, l; };
__device__ __forceinline__ void st_reset(St& S) { S.o0 = f32x16{}; S.o1 = f32x16{}; S.m = -INFINITY; S.l = 0.f; }
__device__ __forceinline__ void qkt(f32x16& p0, f32x16& p1, lcp Kt, const bf16x8 (&qr)[4], int r32, int hi) {
    lcp kb = Kt + hi * 1024 + r32 * 16;
    p0 = f32x16{}; p1 = f32x16{};
#pragma unroll
    for (int ks = 0; ks < 4; ++ks) {
        const bf16x8 b0 = *(LAS const bf16x8*)(kb + ks * 2048), b1 = *(LAS const bf16x8*)(kb + ks * 2048 + 512);
        p0 = __builtin_amdgcn_mfma_f32_32x32x16_bf16(b0, qr[ks], p0, 0, 0, 0);
        p1 = __builtin_amdgcn_mfma_f32_32x32x16_bf16(b1, qr[ks], p1, 0, 0, 0);
    }
}
__device__ __forceinline__ unsigned cvtpk(float lo, float hi) { return pg8::cvt_pk_bf16(lo, hi); }
__device__ __forceinline__ void pv_tile(f32x16& o0, f32x16& o1, lcp Vt, const f32x16& p0, const f32x16& p1, int lane) {
    const int hi = lane >> 5;
    bf16x8 pa[4];
#pragma unroll
    for (int k = 0; k < 2; ++k) {
        v4u w0, w1;
        w0.x = cvtpk(p0[8 * k], p0[8 * k + 1]); w0.y = cvtpk(p0[8 * k + 2], p0[8 * k + 3]); w0.z = cvtpk(p0[8 * k + 4], p0[8 * k + 5]); w0.w = cvtpk(p0[8 * k + 6], p0[8 * k + 7]);
        w1.x = cvtpk(p1[8 * k], p1[8 * k + 1]); w1.y = cvtpk(p1[8 * k + 2], p1[8 * k + 3]); w1.z = cvtpk(p1[8 * k + 4], p1[8 * k + 5]); w1.w = cvtpk(p1[8 * k + 6], p1[8 * k + 7]);
        pa[k] = __builtin_bit_cast(bf16x8, w0); pa[2 + k] = __builtin_bit_cast(bf16x8, w1);
    }
    lcp vb = Vt + ((lane >> 4) & 1) * 32 + (lane & 3) * 8 + (4 * hi + ((lane & 15) >> 2)) * 64;
#pragma unroll
    for (int ks = 0; ks < 4; ++ks) {
        const s16x4 a0 = vtr(vb + ks * 1024), a1 = vtr(vb + ks * 1024 + 512), b0 = vtr(vb + 4096 + ks * 1024), b1 = vtr(vb + 4096 + ks * 1024 + 512);
        const bf16x8 v0 = (bf16x8){a0[0], a0[1], a0[2], a0[3], a1[0], a1[1], a1[2], a1[3]}, v1 = (bf16x8){b0[0], b0[1], b0[2], b0[3], b1[0], b1[1], b1[2], b1[3]};
        o0 = __builtin_amdgcn_mfma_f32_32x32x16_bf16(pa[ks], v0, o0, 0, 0, 0);
        o1 = __builtin_amdgcn_mfma_f32_32x32x16_bf16(pa[ks], v1, o1, 0, 0, 0);
    }
}
struct VFr { s16x4 a[4][2], b[4][2]; };
__device__ __forceinline__ void v_read(VFr& V, lcp Vt, int lane) {
    const int hi = lane >> 5;
    lcp vb = Vt + ((lane >> 4) & 1) * 32 + (lane & 3) * 8 + (4 * hi + ((lane & 15) >> 2)) * 64;
#pragma unroll
    for (int ks = 0; ks < 4; ++ks) { V.a[ks][0] = vtr(vb + ks * 1024); V.a[ks][1] = vtr(vb + ks * 1024 + 512); V.b[ks][0] = vtr(vb + 4096 + ks * 1024); V.b[ks][1] = vtr(vb + 4096 + ks * 1024 + 512); }
}
__device__ __forceinline__ void pv_frags(f32x16& o0, f32x16& o1, const VFr& V, const f32x16& p0, const f32x16& p1) {
    bf16x8 pa[4];
#pragma unroll
    for (int k = 0; k < 2; ++k) {
        v4u w0, w1;
        w0.x = cvtpk(p0[8 * k], p0[8 * k + 1]); w0.y = cvtpk(p0[8 * k + 2], p0[8 * k + 3]); w0.z = cvtpk(p0[8 * k + 4], p0[8 * k + 5]); w0.w = cvtpk(p0[8 * k + 6], p0[8 * k + 7]);
        w1.x = cvtpk(p1[8 * k], p1[8 * k + 1]); w1.y = cvtpk(p1[8 * k + 2], p1[8 * k + 3]); w1.z = cvtpk(p1[8 * k + 4], p1[8 * k + 5]); w1.w = cvtpk(p1[8 * k + 6], p1[8 * k + 7]);
        pa[k] = __builtin_bit_cast(bf16x8, w0); pa[2 + k] = __builtin_bit_cast(bf16x8, w1);
    }
#pragma unroll
    for (int ks = 0; ks < 4; ++ks) {
        const bf16x8 v0 = (bf16x8){V.a[ks][0][0], V.a[ks][0][1], V.a[ks][0][2], V.a[ks][0][3], V.a[ks][1][0], V.a[ks][1][1], V.a[ks][1][2], V.a[ks][1][3]};
        const bf16x8 v1 = (bf16x8){V.b[ks][0][0], V.b[ks][0][1], V.b[ks][0][2], V.b[ks][0][3], V.b[ks][1][0], V.b[ks][1][1], V.b[ks][1][2], V.b[ks][1][3]};
        o0 = __builtin_amdgcn_mfma_f32_32x32x16_bf16(pa[ks], v0, o0, 0, 0, 0);
        o1 = __builtin_amdgcn_mfma_f32_32x32x16_bf16(pa[ks], v1, o1, 0, 0, 0);
    }
}
__device__ __forceinline__ void tile_step(St& S, lcp Kt, lcp Vt, const bf16x8 (&qr)[4], bool rowon, bool EM, int lo, int hin, LAS float* wsf, int lane) {
    const int r32 = lane & 31, hi = lane >> 5;
    f32x16 p0, p1; qkt(p0, p1, Kt, qr, r32, hi);
    VFr VF; v_read(VF, Vt, lane);
    __builtin_amdgcn_sched_barrier(0);
    if (EM) {
        const int lo2 = lo - 4 * hi, hin2 = hin - 4 * hi;
#pragma unroll
        for (int r = 0; r < 16; ++r) { const int kc = crow(r, 0); if (!(kc > lo2 && kc <= hin2)) p0[r] = -INFINITY; if (!(kc + 32 > lo2 && kc + 32 <= hin2)) p1[r] = -INFINITY; }
    }
    float ma = max3f(p0[0], p0[1], p1[0]), mbb = max3f(p0[2], p0[3], p1[1]); ma = max3f(ma, p1[2], p1[3]);
#pragma unroll
    for (int r = 4; r < 16; r += 4) { ma = max3f(ma, p0[r], p0[r + 1]); mbb = max3f(mbb, p0[r + 2], p0[r + 3]); ma = max3f(ma, p1[r], p1[r + 1]); mbb = max3f(mbb, p1[r + 2], p1[r + 3]); }
    float rm = fmaxf(ma, mbb);
    rm = rowon ? rm : -INFINITY;
    rm = swapmax(rm);
    const float mnew = fmaxf(S.m, rm);
    if (__any(mnew > S.m)) {
        const float mb = (mnew == -INFINITY) ? 0.f : mnew;
        const float f = __builtin_amdgcn_exp2f((S.m - mb) * C2);
        S.l *= f;
        if (hi == 0) wsf[r32] = f;
        asm volatile("s_waitcnt lgkmcnt(0)" ::: "memory");
#pragma unroll
        for (int r = 0; r < 16; ++r) { const float fr_ = wsf[crow(r, hi)]; S.o0[r] *= fr_; S.o1[r] *= fr_; }
        asm volatile("s_waitcnt lgkmcnt(0)" ::: "memory");
        S.m = mnew;
    }
    const float mb2 = rowon ? ((S.m == -INFINITY) ? 0.f : S.m * C2) : INFINITY;
    float s0 = 0.f, s1 = 0.f, s2 = 0.f, s3 = 0.f;
#pragma unroll
    for (int r = 0; r < 16; r += 2) { p0[r] = __builtin_amdgcn_exp2f(p0[r] * C2 - mb2); p1[r] = __builtin_amdgcn_exp2f(p1[r] * C2 - mb2); p0[r + 1] = __builtin_amdgcn_exp2f(p0[r + 1] * C2 - mb2); p1[r + 1] = __builtin_amdgcn_exp2f(p1[r + 1] * C2 - mb2);
        s0 += p0[r]; s1 += p1[r]; s2 += p0[r + 1]; s3 += p1[r + 1]; }
    S.l += (s0 + s1) + (s2 + s3);
    pv_frags(S.o0, S.o1, VF, p0, p1);
}

constexpr float ATT_THR = 8.0f;
__device__ __forceinline__ void qkt_c(f32x16& p0, f32x16& p1, lcp Kt, const bf16x8 (&qr)[4], float c0, int r32, int hi) {
    lcp kb = Kt + hi * 1024 + r32 * 16;
#pragma unroll
    for (int r = 0; r < 16; ++r) { p0[r] = c0; p1[r] = c0; }
#pragma unroll
    for (int ks = 0; ks < 4; ++ks) {
        const bf16x8 b0 = *(LAS const bf16x8*)(kb + ks * 2048), b1 = *(LAS const bf16x8*)(kb + ks * 2048 + 512);
        p0 = __builtin_amdgcn_mfma_f32_32x32x16_bf16(b0, qr[ks], p0, 0, 0, 0);
        p1 = __builtin_amdgcn_mfma_f32_32x32x16_bf16(b1, qr[ks], p1, 0, 0, 0);
    }
}
__device__ __forceinline__ void tile_step2(St& S, lcp Kt, lcp Vt, const bf16x8 (&qr)[4], bool rowon, bool EM, int lo, int hin, LAS float* wsf, int lane) {
    const int r32 = lane & 31, hi = lane >> 5;
    f32x16 p0, p1; qkt_c(p0, p1, Kt, qr, rowon ? -S.m : -INFINITY, r32, hi);
    VFr VF; v_read(VF, Vt, lane);
    __builtin_amdgcn_sched_barrier(0);
    if (EM) {
        const int lo2 = lo - 4 * hi, hin2 = hin - 4 * hi;
#pragma unroll
        for (int r = 0; r < 16; ++r) { const int kc = crow(r, 0); if (!(kc > lo2 && kc <= hin2)) p0[r] = -INFINITY; if (!(kc + 32 > lo2 && kc + 32 <= hin2)) p1[r] = -INFINITY; }
    }
    float ma = max3f(p0[0], p0[1], p1[0]), mbb = max3f(p0[2], p0[3], p1[1]); ma = max3f(ma, p1[2], p1[3]);
#pragma unroll
    for (int r = 4; r < 16; r += 4) { ma = max3f(ma, p0[r], p0[r + 1]); mbb = max3f(mbb, p0[r + 2], p0[r + 3]); ma = max3f(ma, p1[r], p1[r + 1]); mbb = max3f(mbb, p1[r + 2], p1[r + 3]); }
    const float rm = swapmax(fmaxf(ma, mbb));
    if (__any(rm > ATT_THR)) {
        const float d = fmaxf(rm, 0.f);
        const float f = __builtin_amdgcn_exp2f(-d);
        S.m += d; S.l *= f;
        if (hi == 0) wsf[r32] = f;
        asm volatile("s_waitcnt lgkmcnt(0)" ::: "memory");
#pragma unroll
        for (int r = 0; r < 16; ++r) { const float fr_ = wsf[crow(r, hi)]; S.o0[r] *= fr_; S.o1[r] *= fr_; p0[r] -= d; p1[r] -= d; }
        asm volatile("s_waitcnt lgkmcnt(0)" ::: "memory");
    }
    float s0 = 0.f, s1 = 0.f, s2 = 0.f, s3 = 0.f;
#pragma unroll
    for (int r = 0; r < 16; r += 2) { p0[r] = __builtin_amdgcn_exp2f(p0[r]); p1[r] = __builtin_amdgcn_exp2f(p1[r]); p0[r + 1] = __builtin_amdgcn_exp2f(p0[r + 1]); p1[r + 1] = __builtin_amdgcn_exp2f(p1[r + 1]);
        s0 += p0[r]; s1 += p1[r]; s2 += p0[r + 1]; s3 += p1[r + 1]; }
    S.l += (s0 + s1) + (s2 + s3);
    pv_frags(S.o0, S.o1, VF, p0, p1);
}
__device__ __forceinline__ void st_reset2(St& S) { S.o0 = f32x16{}; S.o1 = f32x16{}; S.m = 0.f; S.l = 0.f; }
__device__ __forceinline__ void merge(f32x16& f0, f32x16& f1, const St& S, float gate, LAS float* wsf, int lane) {
    const int r32 = lane & 31, hi = lane >> 5;
    const float lt = swapsum(S.l);
    const float coef = gate / fmaxf(lt, 1e-30f);
    asm volatile("s_waitcnt lgkmcnt(0)" ::: "memory");
    if (hi == 0) wsf[r32] = coef;
    asm volatile("s_waitcnt lgkmcnt(0)" ::: "memory");
#pragma unroll
    for (int r = 0; r < 16; ++r) { const float c = wsf[crow(r, hi)]; f0[r] += c * S.o0[r]; f1[r] += c * S.o1[r]; }
    asm volatile("s_waitcnt lgkmcnt(0)" ::: "memory");
}
}

constexpr int ATT_KBUF = 0, ATT_VBUF = 16384, ATT_WSCR = 32768, ATT_WSTRIDE = 6144;
template <int VAR> __device__ __forceinline__ void phase_attn_prompt(const Frame& F, const Args& a, bf16* Oout) {
    using namespace fa;
    const int lane = F.lane, wave = F.wave, tid = F.tid, r32 = lane & 31, hi = lane >> 5;
    LAS char* lds = (LAS char*)F.lds;
    LAS char* wscr = lds + ATT_WSCR + wave * ATT_WSTRIDE;
    LAS float* impL = (LAS float*)wscr; LAS float* scoreL = (LAS float*)(wscr + 4096); LAS float* wsf = (LAS float*)(wscr + 5120); LAS unsigned* maskL = (LAS unsigned*)(wscr + 5376);
    const bf16* QNB = (const bf16*)(a.ws + WS_QNB); const bf16* QRB = (const bf16*)(a.ws + WS_QRB); const float* GA = (const float*)(a.ws + WS_GATES);
    bf16* O = Oout;
    for (int ui = 0; ui < 4; ++ui) {
        int bg, qt;
        if (F.G == 256) { const int s = F.vcu & 7; bg = F.vcu >> 3; qt = (ui == 0) ? s : (ui == 1) ? 15 - s : (ui == 2) ? 16 + s : 31 - s; }
        else { const int u = F.vcu + ui * F.G; if (ui * F.G >= 1024 || u >= 1024) break; bg = u >> 5; qt = u & 31; }
        const int b = bg >> 2, g = bg & 3;
        const int w0 = (qt >= 8) ? qt - 8 : 0, nwin = qt - w0 + 1, nst = 2 + (qt + 1) + nwin;
        const bf16* Kc = (const bf16*)(a.ws + WS_KCB) + (size_t)bg * 128 * 64; const bf16* Vc = (const bf16*)(a.ws + WS_VCB) + (size_t)bg * 128 * 64;
        const bf16* Ks = (const bf16*)(a.ws + WS_KSB) + (size_t)bg * SEQ * 64; const bf16* Vs = (const bf16*)(a.ws + WS_VSB) + (size_t)bg * SEQ * 64;
        const bf16* Kw = (const bf16*)(a.ws + WS_KWB) + (size_t)bg * SEQ * 64; const bf16* Vw = (const bf16*)(a.ws + WS_VWB) + (size_t)bg * SEQ * 64;
        int lo_ = lane; asm volatile("" : "+v"(lo_));
        const int kkey = wave * 8 + (lo_ & 7), kd8 = lo_ >> 3, vkey = wave * 8 + (lo_ >> 3), vd8 = lo_ & 7;
        const int kgo = kkey * 64 + kd8 * 8, vgo = vkey * 64 + vd8 * 8;
        const int klo = kd8 * 1024 + kkey * 16, vlo = (vd8 >> 2) * 4096 + (vkey >> 3) * 512 + (vkey & 7) * 64 + (vd8 & 3) * 16;
        const int tl = 8 * wave + (r32 >> 2), t = 64 * qt + tl, head = 4 * g + (r32 & 3);
        const size_t trow = (size_t)b * SEQ + t;
        const float g0 = GA[trow * 48 + head * 3], g1 = GA[trow * 48 + head * 3 + 1], g2 = GA[trow * 48 + head * 3 + 2];
        bf16x8 qr[4];
#pragma unroll
        for (int ks = 0; ks < 4; ++ks) qr[ks] = *(const bf16x8*)(QNB + trow * DM + head * 64 + ks * 16 + hi * 8);
        v4u kr0, vr0, kr1, vr1, kr2, vr2;
#define ATT_SRC(st, kp, vp) do { if ((st) < 2) { kp = Kc + (st) * 4096; vp = Vc + (st) * 4096; } else if ((st) < 3 + qt) { kp = Ks + ((st) - 2) * 4096; vp = Vs + ((st) - 2) * 4096; } \
                                 else { kp = Kw + (w0 + (st) - 3 - qt) * 4096; vp = Vw + (w0 + (st) - 3 - qt) * 4096; } } while (0)
#define ATT_LOAD(st, KR, VR) do { const bf16* kp_; const bf16* vp_; ATT_SRC(st, kp_, vp_); KR = *(const v4u*)(kp_ + kgo); VR = *(const v4u*)(vp_ + vgo); } while (0)
#define ATT_WRITE(buf, KR, VR) do { *(LAS v4u*)(lds + ATT_KBUF + (buf) * 8192 + klo) = KR; *(LAS v4u*)(lds + ATT_VBUF + (buf) * 8192 + vlo) = VR; } while (0)
        ATT_LOAD(0, kr0, vr0); ATT_LOAD(1, kr1, vr1); ATT_LOAD(2, kr2, vr2);
        __builtin_amdgcn_sched_barrier(0);
        __syncthreads();
        ATT_WRITE(0, kr0, vr0); ATT_WRITE(1, kr1, vr1);
        __syncthreads();
        if (3 < nst) ATT_LOAD(3, kr0, vr0);
        if (4 < nst) ATT_LOAD(4, kr1, vr1);
        St S; st_reset(S);
        f32x16 fin0, fin1;
        unsigned selmask = 0xffffffffu;
        {
            const int nv2 = ((t >= 31) ? (t - 31) / 16 + 1 : 0) - 4 * hi;
            const int ntile = (qt <= 15) ? 1 : 2;
            float cm = -INFINITY, cl = 0.f;
#pragma unroll 1
            for (int T = 0; T < ntile; ++T) {
                f32x16 p0, p1; qkt(p0, p1, (lcp)(lds + ATT_KBUF + T * 8192), qr, r32, hi);
                float rm = -INFINITY;
#pragma unroll
                for (int r = 0; r < 16; ++r) { const int kc = crow(r, 0) + 64 * T; if (!(kc < nv2)) p0[r] = -INFINITY; if (!(kc + 32 < nv2)) p1[r] = -INFINITY; rm = fmaxf(rm, fmaxf(p0[r], p1[r])); }
                rm = swapmax(rm);
                const float mnew = fmaxf(cm, rm), mb = (mnew == -INFINITY) ? 0.f : mnew;
                float sum = 0.f;
#pragma unroll
                for (int r = 0; r < 16; ++r) sum += __builtin_amdgcn_exp2f((p0[r] - mb) * C2) + __builtin_amdgcn_exp2f((p1[r] - mb) * C2);
                cl = cl * __builtin_amdgcn_exp2f((cm - mb) * C2) + sum; cm = mnew;
            }
            const float inv = 1.0f / fmaxf(swapsum(cl), 1e-30f), mb2 = (cm == -INFINITY) ? 0.f : cm * C2;
#pragma unroll 1
            for (int T = 0; T < ntile; ++T) {
                f32x16 p0, p1; qkt(p0, p1, (lcp)(lds + ATT_KBUF + T * 8192), qr, r32, hi);
#pragma unroll
                for (int r = 0; r < 16; ++r) { const int kc = crow(r, 0) + 64 * T;
                    p0[r] = (kc < nv2) ? __builtin_amdgcn_exp2f(p0[r] * C2 - mb2) * inv : 0.f; p1[r] = (kc + 32 < nv2) ? __builtin_amdgcn_exp2f(p1[r] * C2 - mb2) * inv : 0.f; }
                if (qt > 15) {
#pragma unroll
                for (int r = 0; r < 16; ++r) {
                    float v0 = p0[r], v1 = p1[r];
                    v0 += __shfl_xor(v0, 1); v0 += __shfl_xor(v0, 2); v1 += __shfl_xor(v1, 1); v1 += __shfl_xor(v1, 2);
                    if ((r32 & 3) == 0) { LAS float* ip = impL + (r32 >> 2) * 128 + 64 * T + crow(r, hi); ip[0] = v0; ip[32] = v1; }
                } }
                pv_tile(S.o0, S.o1, (lcp)(lds + ATT_VBUF + T * 8192), p0, p1, lane);
            }
            asm volatile("s_waitcnt lgkmcnt(0)" ::: "memory");
            if (qt <= 15) selmask = 0xffffffffu >> (31 - qt);
            else { const int tk = lane >> 3, j4 = lane & 7; float sj[4];
#pragma unroll
              for (int jj = 0; jj < 4; ++jj) { const int j = 4 * j4 + jj; float imp = 0.f;
#pragma unroll
                  for (int n = -1; n <= 3; ++n) { const int nn = 4 * j + n; if (nn >= 0) imp += impL[tk * 128 + nn]; }
                  const bool forced = (j == 0) || (j == qt) || (j == qt - 1), valid = j <= qt;
                  sj[jj] = forced ? INFINITY : (valid ? imp : -INFINITY); scoreL[tk * 32 + j] = sj[jj]; }
              asm volatile("s_waitcnt lgkmcnt(0)" ::: "memory");
              int rk0 = 0, rk1 = 0, rk2 = 0, rk3 = 0;
              for (int i = 0; i < 32; ++i) { const float si = scoreL[tk * 32 + i]; const int j = 4 * j4;
                  rk0 += (si > sj[0] || (si == sj[0] && i < j)) ? 1 : 0; rk1 += (si > sj[1] || (si == sj[1] && i < j + 1)) ? 1 : 0;
                  rk2 += (si > sj[2] || (si == sj[2] && i < j + 2)) ? 1 : 0; rk3 += (si > sj[3] || (si == sj[3] && i < j + 3)) ? 1 : 0; }
              unsigned bits = 0u;
              if (rk0 < 16 && sj[0] > -INFINITY) bits |= 1u << (4 * j4);
              if (rk1 < 16 && sj[1] > -INFINITY) bits |= 2u << (4 * j4);
              if (rk2 < 16 && sj[2] > -INFINITY) bits |= 4u << (4 * j4);
              if (rk3 < 16 && sj[3] > -INFINITY) bits |= 8u << (4 * j4);
              bits |= __shfl_xor(bits, 1); bits |= __shfl_xor(bits, 2); bits |= __shfl_xor(bits, 4);
              if (j4 == 0) maskL[tk] = bits;
              asm volatile("s_waitcnt lgkmcnt(0)" ::: "memory");
              selmask = maskL[r32 >> 2];
              asm volatile("s_waitcnt lgkmcnt(0)" ::: "memory"); }
            fin0 = f32x16{}; fin1 = f32x16{};
            S.l = 0.5f;
            merge(fin0, fin1, S, g0, wsf, lane); st_reset2(S);
#pragma unroll
            for (int ks = 0; ks < 4; ++ks) { const bf16x8 qv = *(const bf16x8*)(QRB + trow * DM + head * 64 + ks * 16 + hi * 8);
                v4u w;
#pragma unroll
                for (int e = 0; e < 4; ++e) { const unsigned lo16 = (unsigned short)qv[2 * e], hi16 = (unsigned short)qv[2 * e + 1];
                    w[e] = cvtpk(__builtin_bit_cast(float, lo16 << 16) * C2, __builtin_bit_cast(float, hi16 << 16) * C2); }
                qr[ks] = __builtin_bit_cast(bf16x8, w); }
            __syncthreads();
            ATT_WRITE(0, kr2, vr2);
            __syncthreads();
        }
#define ATT_STEP(ST, KL, VL, KW, VW) do { const int st_ = (ST); \
            if (VAR != 1 && st_ + 3 < nst) ATT_LOAD(st_ + 3, KL, VL); \
            lcp Kt = (lcp)(lds + ATT_KBUF + (st_ & 1) * 8192); lcp Vt = (lcp)(lds + ATT_VBUF + (st_ & 1) * 8192); \
            const bool slc = st_ < 3 + qt; \
            const int kt = slc ? st_ - 2 : w0 + st_ - 3 - qt; \
            const bool on = slc ? ((selmask >> kt) & 1u) : true; \
            const bool em = (kt == qt) || (!slc && kt == qt - 8); \
            const int lo = (!slc && kt == qt - 8) ? tl : -1, hin = (kt == qt) ? tl : 63; \
            if (VAR != 1) { if (st_ + 1 < nst) ATT_WRITE((st_ + 1) & 1, KW, VW); }     \
            if (VAR != 2) tile_step2(S, Kt, Vt, qr, on, em, lo, hin, wsf, lane); \
            if (kt == qt) { merge(fin0, fin1, S, slc ? g1 : g2, wsf, lane); st_reset2(S); } \
            if (VAR != 1) { __syncthreads(); } } while (0)
#pragma unroll 1
        for (int st = 2; st < nst; st += 3) {
            ATT_STEP(st, kr2, vr2, kr0, vr0);
            if (st + 1 < nst) ATT_STEP(st + 1, kr0, vr0, kr1, vr1);
            if (st + 2 < nst) ATT_STEP(st + 2, kr1, vr1, kr2, vr2);
        }
#undef ATT_STEP
#pragma unroll
        for (int r = 0; r < 16; ++r) { const int q = crow(r, hi); bf16* op = O + ((size_t)b * SEQ + 64 * qt + 8 * wave + (q >> 2)) * DM + (4 * g + (q & 3)) * 64 + r32;
            op[0] = (bf16)f2bf(fin0[r]); op[32] = (bf16)f2bf(fin1[r]); }
#undef ATT_SRC
#undef ATT_LOAD
#undef ATT_WRITE
    }
}


namespace fa {
__device__ __forceinline__ bf16x8 pack8(const f32x4& a, const f32x4& b) {
    v4u w; w.x = cvtpk(a.x, a.y); w.y = cvtpk(a.z, a.w); w.z = cvtpk(b.x, b.y); w.w = cvtpk(b.z, b.w); return __builtin_bit_cast(bf16x8, w);
}
__device__ __forceinline__ int offv32(int key, int d8) { return (d8 >> 2) * 2048 + (key >> 3) * 512 + (key & 7) * 64 + (d8 & 3) * 16; }
__device__ __forceinline__ void load_half_f32(const float* base, int nvalid, bool needv, bf16x8 (&kf)[4], LAS char* Vimg, LAS char* Kimg, int lane) {
    typedef unsigned u32x2v __attribute__((ext_vector_type(2)));
    const int r32 = lane & 31, hi = lane >> 5, kq = lane >> 4, pc = lane & 15;
    f32x4 kx[8], vx[8];
#pragma unroll
    for (int i = 0; i < 8; ++i) kx[i] = __builtin_nontemporal_load((const f32x4*)(base + (size_t)min(4 * i + kq, nvalid - 1) * 512 + pc * 4));
    if (needv) {
#pragma unroll
        for (int i = 0; i < 8; ++i) vx[i] = __builtin_nontemporal_load((const f32x4*)(base + 256 + (size_t)min(4 * i + kq, nvalid - 1) * 512 + pc * 4));
    }
    __builtin_amdgcn_sched_barrier(0);
#pragma unroll
    for (int i = 0; i < 8; ++i) { u32x2v w; w.x = cvtpk(kx[i].x, kx[i].y); w.y = cvtpk(kx[i].z, kx[i].w); *(LAS u32x2v*)(Kimg + (4 * i + kq) * 144 + pc * 8) = w; }
    if (needv) {
#pragma unroll
        for (int i = 0; i < 8; ++i) { u32x2v w; w.x = cvtpk(vx[i].x, vx[i].y); w.y = cvtpk(vx[i].z, vx[i].w); *(LAS u32x2v*)(Vimg + offv32(4 * i + kq, pc >> 1) + (pc & 1) * 8) = w; }
    }
    asm volatile("s_waitcnt lgkmcnt(0)" ::: "memory");
#pragma unroll
    for (int ks = 0; ks < 4; ++ks) kf[ks] = *(const LAS bf16x8*)(Kimg + r32 * 144 + ks * 32 + hi * 16);
    asm volatile("s_waitcnt lgkmcnt(0)" ::: "memory");
}
__device__ __forceinline__ void load_half_bf16(const bf16* Kb, const bf16* Vb, bool needv, bf16x8 (&kf)[4], LAS char* Vimg, int lane) {
    const int r32 = lane & 31, hi = lane >> 5;
#pragma unroll
    for (int ks = 0; ks < 4; ++ks) kf[ks] = *(const bf16x8*)(Kb + r32 * 64 + 16 * ks + 8 * hi);
    if (needv) {
        bf16x8 vx[4];
#pragma unroll
        for (int i = 0; i < 4; ++i) vx[i] = *(const bf16x8*)(Vb + ((lane >> 3) + 8 * i) * 64 + (lane & 7) * 8);
#pragma unroll
        for (int i = 0; i < 4; ++i) *(LAS bf16x8*)(Vimg + offv32((lane >> 3) + 8 * i, lane & 7)) = vx[i];
    }
    asm volatile("s_waitcnt lgkmcnt(0)" ::: "memory");
}
__device__ __forceinline__ void qk_half(f32x16& p, const bf16x8 (&kf)[4], const bf16x8 (&qr)[4]) {
    p = f32x16{};
#pragma unroll
    for (int ks = 0; ks < 4; ++ks) p = __builtin_amdgcn_mfma_f32_32x32x16_bf16(kf[ks], qr[ks], p, 0, 0, 0);
}
__device__ __forceinline__ void pv_half(f32x16& o0, f32x16& o1, lcp Vt, const f32x16& p, int lane) {
    const int hi = lane >> 5;
    bf16x8 pa[2];
#pragma unroll
    for (int k = 0; k < 2; ++k) { v4u w; w.x = cvtpk(p[8 * k], p[8 * k + 1]); w.y = cvtpk(p[8 * k + 2], p[8 * k + 3]); w.z = cvtpk(p[8 * k + 4], p[8 * k + 5]); w.w = cvtpk(p[8 * k + 6], p[8 * k + 7]); pa[k] = __builtin_bit_cast(bf16x8, w); }
    lcp vb = Vt + ((lane >> 4) & 1) * 32 + (lane & 3) * 8 + (4 * hi + ((lane & 15) >> 2)) * 64;
#pragma unroll
    for (int ks = 0; ks < 2; ++ks) {
        const s16x4 a0 = vtr(vb + ks * 1024), a1 = vtr(vb + ks * 1024 + 512), b0 = vtr(vb + 2048 + ks * 1024), b1 = vtr(vb + 2048 + ks * 1024 + 512);
        const bf16x8 v0 = (bf16x8){a0[0], a0[1], a0[2], a0[3], a1[0], a1[1], a1[2], a1[3]}, v1 = (bf16x8){b0[0], b0[1], b0[2], b0[3], b1[0], b1[1], b1[2], b1[3]};
        o0 = __builtin_amdgcn_mfma_f32_32x32x16_bf16(pa[ks], v0, o0, 0, 0, 0);
        o1 = __builtin_amdgcn_mfma_f32_32x32x16_bf16(pa[ks], v1, o1, 0, 0, 0);
    }
}
__device__ __forceinline__ void half_step(St& S, const bf16x8 (&kf)[4], lcp Vt, const bf16x8 (&qr)[4], bool rowon, bool EM, int lo, int hin, LAS float* wsf, int lane) {
    const int r32 = lane & 31, hi = lane >> 5;
    f32x16 p; qk_half(p, kf, qr);
    if (EM) { const int lo2 = lo - 4 * hi, hin2 = hin - 4 * hi;
#pragma unroll
        for (int r = 0; r < 16; ++r) { const int kc = crow(r, 0); if (!(kc > lo2 && kc <= hin2)) p[r] = -INFINITY; } }
    float rm = p[0];
#pragma unroll
    for (int r = 1; r < 16; ++r) rm = fmaxf(rm, p[r]);
    rm = rowon ? rm : -INFINITY;
    rm = swapmax(rm);
    const float mnew = fmaxf(S.m, rm);
    if (__any(mnew > S.m)) {
        const float mb = (mnew == -INFINITY) ? 0.f : mnew;
        const float f = __builtin_amdgcn_exp2f((S.m - mb) * C2);
        S.l *= f;
        if (hi == 0) wsf[r32] = f;
        asm volatile("s_waitcnt lgkmcnt(0)" ::: "memory");
#pragma unroll
        for (int r = 0; r < 16; ++r) { const float fr_ = wsf[crow(r, hi)]; S.o0[r] *= fr_; S.o1[r] *= fr_; }
        asm volatile("s_waitcnt lgkmcnt(0)" ::: "memory");
        S.m = mnew;
    }
    const float mb2 = rowon ? ((S.m == -INFINITY) ? 0.f : S.m * C2) : INFINITY;
    float sum = 0.f;
#pragma unroll
    for (int r = 0; r < 16; ++r) { p[r] = __builtin_amdgcn_exp2f(p[r] * C2 - mb2); sum += p[r]; }
    S.l += sum;
    pv_half(S.o0, S.o1, Vt, p, lane);
}
}

constexpr int SA_WREG = 9216, SA_IMP = 73728, SA_PART = 77824, SA_ML = 143360, SA_SEL = 145408;
static_assert(SA_SEL + 64 <= MISC_OFF && 8 * SA_WREG <= SA_IMP && SA_IMP + 3072 <= SA_PART && SA_PART + 16 * 4096 <= SA_ML && SA_ML + 2048 <= SA_SEL, "sample-attention LDS map");
__device__ __forceinline__ void sa_store_partial(const fa::St& S, LAS char* lds, int slot, int lane) {
    const int r32 = lane & 31, hi = lane >> 5;
    LAS float* pp = (LAS float*)(lds + SA_PART + slot * 4096);
#pragma unroll
    for (int r = 0; r < 8; ++r) { const int row = fa::crow(r, hi); pp[row * 64 + r32] = S.o0[r]; pp[row * 64 + 32 + r32] = S.o1[r]; }
    const float lt = fa::swapsum(S.l);
    if (lane < 16) { LAS float* ml = (LAS float*)(lds + SA_ML + slot * 128); ml[2 * lane] = S.m; ml[2 * lane + 1] = lt; }
}
__device__ __forceinline__ void phase_attn_sample(const Frame& F, const Args& a) {
    using namespace fa;
    const int lane = F.lane, wave = F.wave, tid = F.tid, r32 = lane & 31, hi = lane >> 5;
    LAS char* lds = (LAS char*)F.lds;
    LAS char* Vimg = lds + wave * SA_WREG; LAS char* Kimg = Vimg + 4096;
    LAS float* wsf = (LAS float*)(Vimg + 8704);
    LAS float* impL = (LAS float*)(lds + SA_IMP); LAS float* scoreL = (LAS float*)(lds + SA_IMP + 2048);
    LAS unsigned* selL = (LAS unsigned*)(lds + SA_SEL);
    const bf16* QNB = (const bf16*)(a.ws + WS_QNB); const bf16* QRB = (const bf16*)(a.ws + WS_QRB); const float* GA = (const float*)(a.ws + WS_GATES);
    const float* cslc = (const float*)a.in[I_CSLC]; const float* swin = (const float*)a.in[I_SWIN]; const int* pt = (const int*)a.in[I_PT];
    const float* KVS = a.out + O_KVSLC; const float* KVW = (const float*)(a.ws + WS_KVWIN);
    bf16* O = (bf16*)(a.ws + WS_O);
    for (int u = F.vcu; u < 512; u += F.G) {
        const int sidx = u >> 2, g = u & 3;
        const int row16 = r32 & 15, ti = row16 >> 2, head = 4 * g + (row16 & 3);
        const size_t qrow = (size_t)MP + 4 * sidx + ti;
        __syncthreads();
        if (wave == 0) {
            bf16x8 qr[4];
#pragma unroll
            for (int ks = 0; ks < 4; ++ks) qr[ks] = *(const bf16x8*)(QNB + qrow * DM + head * 64 + ks * 16 + hi * 8);
            const bf16* Kc = (const bf16*)(a.ws + WS_KCB) + ((size_t)(8 + sidx) * 4 + g) * 128 * 64; const bf16* Vc = (const bf16*)(a.ws + WS_VCB) + ((size_t)(8 + sidx) * 4 + g) * 128 * 64;
            float cm = -INFINITY, cl = 0.f;
#pragma unroll 1
            for (int h = 0; h < 4; ++h) {
                bf16x8 kf[4]; load_half_bf16(Kc + h * 2048, Vc + h * 2048, false, kf, Vimg, lane);
                f32x16 p; qk_half(p, kf, qr);
                const int nv2 = 127 - 32 * h - 4 * hi; float rm = -INFINITY;
#pragma unroll
                for (int r = 0; r < 16; ++r) { if (!(crow(r, 0) < nv2)) p[r] = -INFINITY; rm = fmaxf(rm, p[r]); }
                rm = swapmax(rm);
                const float mnew = fmaxf(cm, rm); float sum = 0.f;
#pragma unroll
                for (int r = 0; r < 16; ++r) sum += __builtin_amdgcn_exp2f((p[r] - mnew) * C2);
                cl = cl * __builtin_amdgcn_exp2f((cm - mnew) * C2) + sum; cm = mnew;
            }
            const float inv = 1.0f / fmaxf(swapsum(cl), 1e-30f), mb2 = cm * C2;
            St S; st_reset(S);
#pragma unroll 1
            for (int h = 0; h < 4; ++h) {
                bf16x8 kf[4]; load_half_bf16(Kc + h * 2048, Vc + h * 2048, true, kf, Vimg, lane);
                f32x16 p; qk_half(p, kf, qr);
                const int nv2 = 127 - 32 * h - 4 * hi;
#pragma unroll
                for (int r = 0; r < 16; ++r) p[r] = (crow(r, 0) < nv2) ? __builtin_amdgcn_exp2f(p[r] * C2 - mb2) * inv : 0.f;
#pragma unroll
                for (int r = 0; r < 16; ++r) { float v0 = p[r]; v0 += __shfl_xor(v0, 1); v0 += __shfl_xor(v0, 2);
                    if ((r32 & 3) == 0 && r32 < 16) impL[(r32 >> 2) * 128 + 32 * h + crow(r, hi)] = v0; }
                pv_half(S.o0, S.o1, (lcp)Vimg, p, lane);
            }
            S.m = 0.f; S.l = 0.5f;
            sa_store_partial(S, lds, 0, lane);
            asm volatile("s_waitcnt lgkmcnt(0)" ::: "memory");
            { const int tk = lane >> 4, jg = lane & 15; float sj[3];
#pragma unroll
              for (int jj = 0; jj < 3; ++jj) { const int j = 3 * jg + jj; float imp = 0.f;
#pragma unroll
                  for (int n = -1; n <= 3; ++n) { const int nn = 4 * j + n; if (nn >= 0 && nn < 127) imp += impL[tk * 128 + nn]; }
                  const bool forced = (j == 0) || (j == 32) || (j == 31);
                  sj[jj] = forced ? INFINITY : ((j <= 32) ? imp : -INFINITY); scoreL[tk * 64 + j] = sj[jj]; }
              asm volatile("s_waitcnt lgkmcnt(0)" ::: "memory");
              int rk0 = 0, rk1 = 0, rk2 = 0;
              for (int i = 0; i < 33; ++i) { const float si = scoreL[tk * 64 + i]; const int j = 3 * jg;
                  rk0 += (si > sj[0] || (si == sj[0] && i < j)) ? 1 : 0; rk1 += (si > sj[1] || (si == sj[1] && i < j + 1)) ? 1 : 0; rk2 += (si > sj[2] || (si == sj[2] && i < j + 2)) ? 1 : 0; }
              unsigned long long bits = 0ull;
              if (rk0 < 16 && sj[0] > -INFINITY) bits |= 1ull << (3 * jg);
              if (rk1 < 16 && sj[1] > -INFINITY) bits |= 2ull << (3 * jg);
              if (rk2 < 16 && sj[2] > -INFINITY) bits |= 4ull << (3 * jg);
              unsigned blo = (unsigned)bits, bhi = (unsigned)(bits >> 32);
#pragma unroll
              for (int o = 1; o < 16; o <<= 1) { blo |= __shfl_xor(blo, o); bhi |= __shfl_xor(bhi, o); }
              if (jg == 0) { selL[2 * tk] = blo; selL[2 * tk + 1] = bhi; } }
        } else {
            bf16x8 qr[4];
#pragma unroll
            for (int ks = 0; ks < 4; ++ks) qr[ks] = *(const bf16x8*)(QRB + qrow * DM + head * 64 + ks * 16 + hi * 8);
            St S; st_reset(S);
#pragma unroll 1
            for (int it = wave - 1; it < 17; it += 7) {
                bf16x8 kf[4];
                if (it < 16) { load_half_f32(swin + ((size_t)sidx * 512 + 32 * it) * 512 + g * 64, 32, true, kf, Vimg, Kimg, lane);
                    half_step(S, kf, (lcp)Vimg, qr, true, it == 0, ti, 31, wsf, lane); }
                else { load_half_f32(KVW + ((size_t)MP + 4 * sidx) * 512 + g * 64, 4, true, kf, Vimg, Kimg, lane);
                    half_step(S, kf, (lcp)Vimg, qr, true, true, -1, ti, wsf, lane); }
            }
            sa_store_partial(S, lds, wave, lane);
        }
        __syncthreads();
        {
            bf16x8 qr[4];
#pragma unroll
            for (int ks = 0; ks < 4; ++ks) qr[ks] = *(const bf16x8*)(QRB + qrow * DM + head * 64 + ks * 16 + hi * 8);
            const unsigned mlo = selL[2 * ti], mhi = selL[2 * ti + 1];
            const unsigned ulo = selL[0] | selL[2] | selL[4] | selL[6];
            St S; st_reset(S);
            int cnt = 0;
#pragma unroll 1
            for (int j = 0; j < 32; ++j) {
                if (!((ulo >> j) & 1u)) continue;
                const float* bbase = cslc + ((size_t)pt[sidx * 16 + (j >> 1)] * 128 + (j & 1) * 64) * 512 + g * 64;
#pragma unroll 1
                for (int h = 0; h < 2; ++h) {
                    if ((cnt++ & 7) != wave) continue;
                    bf16x8 kf[4]; load_half_f32(bbase + (size_t)h * 32 * 512, 32, true, kf, Vimg, Kimg, lane);
                    half_step(S, kf, (lcp)Vimg, qr, (mlo >> j) & 1u, false, 0, 0, wsf, lane);
                }
            }
            if ((cnt & 7) == wave) {
                bf16x8 kf[4]; load_half_f32(KVS + ((size_t)MP + 4 * sidx) * 512 + g * 64, 4, true, kf, Vimg, Kimg, lane);
                half_step(S, kf, (lcp)Vimg, qr, mhi & 1u, true, -1, ti, wsf, lane);
            }
            sa_store_partial(S, lds, 8 + wave, lane);
        }
        __syncthreads();
        {
            const int row = tid >> 5, d = (tid & 31) * 2;
            const size_t orow = (size_t)MP + 4 * sidx + (row >> 2); const int oh = 4 * g + (row & 3);
            const float g0 = GA[orow * 48 + oh * 3], g1 = GA[orow * 48 + oh * 3 + 1], g2 = GA[orow * 48 + oh * 3 + 2];
            const LAS float* part = (const LAS float*)(lds + SA_PART); const LAS float* ml = (const LAS float*)(lds + SA_ML);
            float r0 = g0 * part[row * 64 + d], r1 = g0 * part[row * 64 + d + 1];
#pragma unroll
            for (int br = 0; br < 2; ++br) {
                const int s0 = br ? 8 : 1, s1 = br ? 16 : 8;
                float Mx = -INFINITY;
                for (int w = s0; w < s1; ++w) Mx = fmaxf(Mx, ml[w * 32 + 2 * row]);
                float L = 0.f, a0 = 0.f, a1 = 0.f;
                for (int w = s0; w < s1; ++w) { const float mw = ml[w * 32 + 2 * row]; const float f = (mw == -INFINITY) ? 0.f : __builtin_amdgcn_exp2f((mw - Mx) * C2);
                    L += f * ml[w * 32 + 2 * row + 1]; a0 += f * part[w * 1024 + row * 64 + d]; a1 += f * part[w * 1024 + row * 64 + d + 1]; }
                const float c = (br ? g1 : g2) / fmaxf(L, 1e-30f);
                r0 += c * a0; r1 += c * a1;
            }
            *(unsigned*)(O + orow * DM + oh * 64 + d) = pk2(r0, r1);
        }
    }
}


__device__ __forceinline__ void phase_compress_fast(const Frame& F, const Args& a, const int u_lo, const int u_hi, const int ubase, const int ustride) {
    using namespace fa;
    const int lane = F.lane, wave = F.wave, tid = F.tid, r32 = lane & 31, hi = lane >> 5;
    LAS float* PL = (LAS float*)F.lds + wave * 4096;
    LAS char* BL = (LAS char*)F.lds;
    LAS char* AL = (LAS char*)F.lds + 65536 + wave * 6656;
    const int* pt = (const int*)a.in[I_PT]; const float* cc = (const float*)a.in[I_CCMP];
    const float* knc = (const float*)a.in[I_KNC];
    const int g = wave >> 1, kv = wave & 1;
    for (int u = u_lo + ubase; u < u_hi; u += ustride) {
        const int seq = u / 5, jt = u % 5;
        const float* abase = (seq < 8) ? a.out + O_KVCMP + (size_t)seq * SEQ * 512 : cc;
        __syncthreads();
        LAS unsigned* RA = (LAS unsigned*)(AL + 4608) + lane;
#pragma unroll
        for (int i = 0; i < 8; ++i) { const int jj = min(31 * jt + 4 * i + (lane >> 4), 127);
            const unsigned rowi = (seq < 8) ? (unsigned)(16 * jj) : (unsigned)pt[(seq - 8) * 16 + (jj >> 3)] * 128u + (unsigned)((16 * jj) & 127);
            RA[64 * i] = rowi * 512u + (unsigned)(kv * 256 + g * 64 + (lane & 15) * 4); }
        asm volatile("s_waitcnt lgkmcnt(0)" ::: "memory");
        const int awo = (lane >> 4) * 144 + (lane & 15) * 8, aro = r32 * 144 + hi * 64;
        f32x16 acc[4];
#pragma unroll
        for (int c = 0; c < 4; ++c) acc[c] = f32x16{};
        f32x4 xa[8], xb[8], xc[8]; v4u br0[4], br1[4];
        const bf16* wtb = (const bf16*)(a.ws + WS_CWT) + tid * 8;
#define CMP_LDA(X, LL) do { _Pragma("unroll") for (int i = 0; i < 8; ++i) X[i] = __builtin_nontemporal_load((const f32x4*)(abase + (RA[64 * i] + (unsigned)((LL) * 512)))); } while (0)
#define CMP_LDB(BR, LL) do { _Pragma("unroll") for (int i = 0; i < 4; ++i) BR[i] = *(const v4u*)(wtb + ((LL) * 8192 + (i & 1) * 4096 + (i >> 1) * 131072)); } while (0)
#define CMP_STB(BR, BUF) do { _Pragma("unroll") for (int i = 0; i < 4; ++i) *(LAS v4u*)(BL + (BUF) * 32768 + (tid + 512 * i) * 16) = BR[i]; } while (0)
        CMP_LDB(br0, 0); CMP_LDA(xa, 0); CMP_LDA(xb, 1); CMP_LDB(br1, 1);
        CMP_STB(br0, 0);
        __syncthreads();
#define CMP_STEP(LL, XC, XN, BW, BLD) do { const int l_ = (LL); \
            if (l_ + 2 < 16) { CMP_LDA(XN, l_ + 2); CMP_LDB(BLD, l_ + 2); } \
            __builtin_amdgcn_sched_barrier(0); \
            _Pragma("unroll") for (int i = 0; i < 8; ++i) { typedef unsigned u32x2v __attribute__((ext_vector_type(2))); u32x2v w; w.x = cvtpk(XC[i].x, XC[i].y); w.y = cvtpk(XC[i].z, XC[i].w); \
                *(LAS u32x2v*)(AL + i * 576 + awo) = w; } \
            asm volatile("s_waitcnt lgkmcnt(0)" ::: "memory"); \
            { lcp bb = (lcp)(BL + (l_ & 1) * 32768 + kv * 16384 + lane * 16); \
              _Pragma("unroll") for (int sx = 0; sx < 4; ++sx) { const bf16x8 af = *(const LAS bf16x8*)(AL + aro + sx * 16); \
                _Pragma("unroll") for (int c = 0; c < 4; ++c) { const bf16x8 bf = *(LAS const bf16x8*)(bb + (sx * 4 + c) * 1024); acc[c] = __builtin_amdgcn_mfma_f32_32x32x16_bf16(af, bf, acc[c], 0, 0, 0); } \
                if (sx & 1) __builtin_amdgcn_sched_barrier(0); } } \
            __builtin_amdgcn_sched_barrier(0); \
            if (l_ + 1 < 16) CMP_STB(BW, (l_ + 1) & 1); \
            __syncthreads(); } while (0)
#pragma unroll 1
        for (int l0 = 0; l0 < 16; l0 += 6) {
            CMP_STEP(l0, xa, xc, br1, br0);
            CMP_STEP(l0 + 1, xb, xa, br0, br1);
            CMP_STEP(l0 + 2, xc, xb, br1, br0);
            CMP_STEP(l0 + 3, xa, xc, br0, br1);
            if (l0 + 4 < 16) { CMP_STEP(l0 + 4, xb, xa, br1, br0); CMP_STEP(l0 + 5, xc, xb, br0, br1); }
        }
#undef CMP_LDA
#undef CMP_LDB
#undef CMP_STB
#undef CMP_STEP
        asm volatile("s_waitcnt lgkmcnt(0)" ::: "memory");
#pragma unroll
        for (int c = 0; c < 4; ++c)
#pragma unroll
            for (int r = 0; r < 16; ++r) PL[crow(r, hi) * 128 + 32 * c + r32] = acc[c][r];
        asm volatile("s_waitcnt lgkmcnt(0)" ::: "memory");
        {   const int nl = lane >> 1, e0 = 32 * (lane & 1), n = 31 * jt + nl;
            const bool live = (nl < 31) && (n < 127);
            if (live || n == 127) {
                const float* bias = (const float*)(a.ws + WS_CBIAS) + kv * 64 + e0;
                float v[32]; float ss = 0.f;
#pragma unroll
                for (int i = 0; i < 32; ++i) { v[i] = live ? PL[nl * 128 + e0 + i] + PL[(nl + 1) * 128 + 64 + e0 + i] + bias[i] : 0.f; ss += v[i] * v[i]; }
                if (!kv) { ss += __shfl_xor(ss, 1); const float rs = 1.0f / sqrtf(ss * (1.f / 64) + EPS);
#pragma unroll
                    for (int i = 0; i < 32; ++i) v[i] = v[i] * rs * knc[e0 + i]; }
                bf16* bd = (bf16*)(a.ws + (kv ? WS_VCB : WS_KCB)) + (((size_t)seq * 4 + g) * 128 + n) * 64 + e0;
#pragma unroll
                for (int i = 0; i < 4; ++i) { v4u w; w.x = pk2(v[8 * i], v[8 * i + 1]); w.y = pk2(v[8 * i + 2], v[8 * i + 3]); w.z = pk2(v[8 * i + 4], v[8 * i + 5]); w.w = pk2(v[8 * i + 6], v[8 * i + 7]); *(v4u*)(bd + 8 * i) = w; }
            }
        }
        asm volatile("s_waitcnt lgkmcnt(0)" ::: "memory");
    }
}

__device__ __forceinline__ void ln_row_stats(const float* LNP, size_t row, int q, float& mean, float& rstd) {
    const f32x4* p = (const f32x4*)(LNP + (row * 32 + 8 * q) * 2);
    float sm = 0.f, sq = 0.f;
#pragma unroll
    for (int i = 0; i < 4; ++i) { const f32x4 v = p[i]; sm += v.x + v.z; sq += v.y + v.w; }
    sm += __shfl_xor(sm, 1); sm += __shfl_xor(sm, 2); sq += __shfl_xor(sq, 1); sq += __shfl_xor(sq, 2);
    mean = sm * (1.f / DA); const float var = fmaxf(sq * (1.f / DA) - mean * mean, 0.f); rstd = 1.0f / sqrtf(var + EPS);
}
__device__ __forceinline__ void phase_spatial_fast(const Frame& F, const Args& a, const int l) {
    using namespace fa;
    const int lane = F.lane, wave = F.wave, tid = F.tid, r32 = lane & 31, hi = lane >> 5;
    LAS char* lds = (LAS char*)F.lds;
    LAS float* stL = (LAS float*)(lds + 65536);
    LAS char* WFL = lds + 69632;
    int g_prev = -1;
    const bf16* UV = (const bf16*)(a.ws + WS_UV); const float* LNP = (const float*)(a.ws + WS_LNP); bf16* GT = (bf16*)(a.ws + WS_GATED);
    const float* lng = (const float*)a.in[I_ALNG] + l * DA; const float* lnb = (const float*)a.in[I_ALNB] + l * DA;
    const float* wsp = (const float*)a.in[I_AWS] + (size_t)l * 8 * 128 * 128; const float* bsp = (const float*)a.in[I_ABS] + l * 8 * 128;
    v4u vq[8]; f32x4 lp[4];
    if (F.vcu < 1024) { const int u = F.vcu; const size_t row0 = (size_t)(u >> 3) * 128; const int chn = (u & 7) * 256 + (tid & 31) * 8;
#pragma unroll
        for (int i = 0; i < 8; ++i) vq[i] = *(const v4u*)(UV + (row0 + (tid >> 5) + 16 * i) * 4096 + 2048 + chn);
        const f32x4* p = (const f32x4*)(LNP + ((row0 + (tid >> 2)) * 32 + 8 * (tid & 3)) * 2);
#pragma unroll
        for (int i = 0; i < 4; ++i) lp[i] = p[i]; }
    float gg[8], bb[8], btv[4]; int g_par = -1;
    for (int u = F.vcu; u < 1024; u += F.G) {
        const int c = u >> 3, g = u & 7;
        const size_t row0 = (size_t)c * 128; const int ch0 = g * 256;
        if (g != g_par) { const int chn = ch0 + (tid & 31) * 8;
#pragma unroll
            for (int i = 0; i < 8; ++i) { gg[i] = lng[chn + i]; bb[i] = lnb[chn + i]; }
#pragma unroll
            for (int tt = 0; tt < 4; ++tt) btv[tt] = bsp[g * 128 + 32 * tt + r32];
            g_par = g; }
        v4u uq[8];
        {   const int chu = ch0 + 32 * wave + 8 * (lane & 3);
#pragma unroll
            for (int i = 0; i < 8; ++i) uq[i] = *(const v4u*)(UV + (row0 + 16 * i + (lane >> 2)) * 4096 + chu); }
        __builtin_amdgcn_sched_barrier(0);
        float mean_t, rstd_t;
        {   float sm = 0.f, sq = 0.f;
#pragma unroll
            for (int i = 0; i < 4; ++i) { sm += lp[i].x + lp[i].z; sq += lp[i].y + lp[i].w; }
            sm += __shfl_xor(sm, 1); sm += __shfl_xor(sm, 2); sq += __shfl_xor(sq, 1); sq += __shfl_xor(sq, 2);
            mean_t = sm * (1.f / DA); const float var = fmaxf(sq * (1.f / DA) - mean_t * mean_t, 0.f); rstd_t = 1.0f / sqrtf(var + EPS); }
        __syncthreads();
        if ((tid & 3) == 0) { stL[2 * (tid >> 2)] = mean_t; stL[2 * (tid >> 2) + 1] = rstd_t; }
        __syncthreads();
        {
            const int ck = tid & 31;
#pragma unroll
            for (int i = 0; i < 8; ++i) {
                const int sr = (tid >> 5) + 16 * i;
                const float mean = stL[2 * sr], rstd = stL[2 * sr + 1];
                const v4u vv = vq[i];
                v4u o;
#pragma unroll
                for (int e = 0; e < 4; ++e) { const unsigned ww = vv[e];
                    o[e] = pk2((__builtin_bit_cast(float, ww << 16) - mean) * rstd * gg[2 * e] + bb[2 * e], (__builtin_bit_cast(float, ww & 0xffff0000u) - mean) * rstd * gg[2 * e + 1] + bb[2 * e + 1]); }
                *(LAS v4u*)(lds + (ck >> 2) * 8192 + (sr >> 3) * 512 + (sr & 7) * 64 + (ck & 3) * 16) = o;
            }
        }
        if (g != g_prev) {
            const float* wg = wsp + (size_t)g * 128 * 128;
            for (int cell = tid; cell < 20 * 64; cell += NTHR) {
                const int f = cell >> 6, ln = cell & 63, tt = (f >= 12) ? 3 : (f >= 6) ? 2 : (f >= 2) ? 1 : 0, ks = f - tt * (tt + 1), rr = ln & 31, hh = ln >> 5;
                const int t = 32 * tt + rr, sb = 16 * ks + 4 * hh;
                const float* wp = wg + (size_t)t * 128 + sb;
                f32x4 x0 = *(const f32x4*)wp, x1 = *(const f32x4*)(wp + 8);
                x0.x = (sb + 0 <= t) ? x0.x : 0.f; x0.y = (sb + 1 <= t) ? x0.y : 0.f; x0.z = (sb + 2 <= t) ? x0.z : 0.f; x0.w = (sb + 3 <= t) ? x0.w : 0.f;
                x1.x = (sb + 8 <= t) ? x1.x : 0.f; x1.y = (sb + 9 <= t) ? x1.y : 0.f; x1.z = (sb + 10 <= t) ? x1.z : 0.f; x1.w = (sb + 11 <= t) ? x1.w : 0.f;
                *(LAS bf16x8*)(WFL + cell * 16) = pack8(x0, x1);
            }
            g_prev = g;
        }
        __builtin_amdgcn_sched_barrier(0);
        if (u + F.G < 1024) { const int un = u + F.G; const size_t rown = (size_t)(un >> 3) * 128; const int chn = (un & 7) * 256 + (tid & 31) * 8;
#pragma unroll
            for (int i = 0; i < 8; ++i) vq[i] = *(const v4u*)(UV + (rown + (tid >> 5) + 16 * i) * 4096 + 2048 + chn);
            const f32x4* p = (const f32x4*)(LNP + ((rown + (tid >> 2)) * 32 + 8 * (tid & 3)) * 2);
#pragma unroll
            for (int i = 0; i < 4; ++i) lp[i] = p[i]; }
        __builtin_amdgcn_sched_barrier(0);
        __syncthreads();
        f32x16 acc[4];
#pragma unroll
        for (int tt = 0; tt < 4; ++tt) acc[tt] = f32x16{};
        lcp vb = (lcp)(lds + wave * 8192 + ((lane >> 4) & 1) * 32 + (lane & 3) * 8 + (4 * hi + ((lane & 15) >> 2)) * 64);
#pragma unroll
        for (int ks = 0; ks < 8; ++ks) {
            const s16x4 a0 = vtr(vb + ks * 1024), a1 = vtr(vb + ks * 1024 + 512);
            const bf16x8 vf = (bf16x8){a0[0], a0[1], a0[2], a0[3], a1[0], a1[1], a1[2], a1[3]};
#pragma unroll
            for (int tt = 0; tt < 4; ++tt) {
                if (ks > 2 * tt + 1) continue;
                const bf16x8 wf = *(const LAS bf16x8*)(WFL + ((tt * (tt + 1) + ks) * 64 + lane) * 16);
                acc[tt] = __builtin_amdgcn_mfma_f32_32x32x16_bf16(vf, wf, acc[tt], 0, 0, 0);
            }
        }
        asm volatile("s_waitcnt lgkmcnt(0)" ::: "memory");
        LAS bf16* sl = (LAS bf16*)(lds + wave * 8192);
#pragma unroll
        for (int tt = 0; tt < 4; ++tt) { const int t = 32 * tt + r32; const float bt = btv[tt];
#pragma unroll
            for (int q4 = 0; q4 < 4; ++q4) {
                typedef unsigned u32x2v __attribute__((ext_vector_type(2)));
                u32x2v w; w.x = cvtpk(acc[tt][4 * q4] + bt, acc[tt][4 * q4 + 1] + bt); w.y = cvtpk(acc[tt][4 * q4 + 2] + bt, acc[tt][4 * q4 + 3] + bt);
                *(LAS u32x2v*)(sl + t * 32 + 8 * q4 + 4 * hi) = w; } }
        asm volatile("s_waitcnt lgkmcnt(0)" ::: "memory");
        const int chn = ch0 + 32 * wave + 8 * (lane & 3);
#pragma unroll
        for (int i = 0; i < 8; ++i) { const int t = 16 * i + (lane >> 2);
            const v4u sv = *(const LAS v4u*)(sl + t * 32 + 8 * (lane & 3));
            const v4u uu = uq[i];
            v4u o;
#pragma unroll
            for (int e = 0; e < 4; ++e) o[e] = pk2(__builtin_bit_cast(float, uu[e] << 16) * __builtin_bit_cast(float, sv[e] << 16), __builtin_bit_cast(float, uu[e] & 0xffff0000u) * __builtin_bit_cast(float, sv[e] & 0xffff0000u));
            *(v4u*)(GT + (row0 + t) * DA + chn) = o; }
    }
}
__device__ __forceinline__ void phase_spatial_sample(const Frame& F, const Args& a, const int l) {
    const int tid = F.tid;
    LAS float* stL = (LAS float*)F.lds;
    const bf16* UV = (const bf16*)(a.ws + WS_UV); const float* LNP = (const float*)(a.ws + WS_LNP); bf16* GT = (bf16*)(a.ws + WS_GATED);
    const float* lng = (const float*)a.in[I_ALNG] + l * DA; const float* lnb = (const float*)a.in[I_ALNB] + l * DA;
    const float* wsp = (const float*)a.in[I_AWS] + (size_t)l * 8 * 128 * 128; const float* bsp = (const float*)a.in[I_ABS] + l * 8 * 128;
    float* av = a.out + O_AV + (size_t)l * 128 * 4 * DA;
    for (int sidx = F.vcu; sidx < 128; sidx += F.G) {
        const size_t row0 = (size_t)MP + 4 * sidx;
        __syncthreads();
        if (tid < 64) { float mean, rstd; ln_row_stats(LNP, row0 + ((tid >> 2) & 3), tid & 3, mean, rstd); if (tid < 16 && (tid & 3) == 0) { stL[2 * (tid >> 2)] = mean; stL[2 * (tid >> 2) + 1] = rstd; } }
        __syncthreads();
        const int c = tid * 4, g = c >> 8;
        const f32x4 gg = *(const f32x4*)(lng + c), bb = *(const f32x4*)(lnb + c);
        f32x4 vl[4];
#pragma unroll
        for (int tt = 0; tt < 4; ++tt) { const float mean = stL[2 * tt], rstd = stL[2 * tt + 1];
            const unsigned long long vv = *(const unsigned long long*)(UV + (row0 + tt) * 4096 + 2048 + c); const unsigned w0 = (unsigned)vv, w1 = (unsigned)(vv >> 32);
            vl[tt].x = (__builtin_bit_cast(float, w0 << 16) - mean) * rstd * gg.x + bb.x; vl[tt].y = (__builtin_bit_cast(float, w0 & 0xffff0000u) - mean) * rstd * gg.y + bb.y;
            vl[tt].z = (__builtin_bit_cast(float, w1 << 16) - mean) * rstd * gg.z + bb.z; vl[tt].w = (__builtin_bit_cast(float, w1 & 0xffff0000u) - mean) * rstd * gg.w + bb.w;
            *(f32x4*)(av + ((size_t)sidx * 4 + tt) * DA + c) = vl[tt]; }
#pragma unroll
        for (int tt = 0; tt < 4; ++tt) { f32x4 sv = (f32x4){0.f, 0.f, 0.f, 0.f};
#pragma unroll
            for (int sx = 0; sx <= tt; ++sx) sv = sv + vl[sx] * wsp[((size_t)g * 128 + tt) * 128 + sx];
            sv = sv + bsp[g * 128 + tt];
            const unsigned long long uu = *(const unsigned long long*)(UV + (row0 + tt) * 4096 + c); const unsigned w0 = (unsigned)uu, w1 = (unsigned)(uu >> 32);
            *(unsigned long long*)(GT + (row0 + tt) * DA + c) = (unsigned long long)pk2(__builtin_bit_cast(float, w0 << 16) * sv.x, __builtin_bit_cast(float, w0 & 0xffff0000u) * sv.y)
                | ((unsigned long long)pk2(__builtin_bit_cast(float, w1 << 16) * sv.z, __builtin_bit_cast(float, w1 & 0xffff0000u) * sv.w) << 32); }
    }
}


template <bool FINAL> __device__ __forceinline__ void skinny_resid(const Frame& F, const bf16* A, const bf16* Bt, const int K, float* Y, bf16* HB, float* SSQ) {
    using namespace fa;
    const int lane = F.lane, wave = F.wave, tid = F.tid, r32 = lane & 31, hi = lane >> 5;
    LAS float* RL = (LAS float*)F.lds;
    LAS char* AL = (LAS char*)F.lds + wave * 13824; LAS char* BL = AL + 4608;
    const int nchunk = K / 64, c_lo = (wave * nchunk) / 8, c_hi = ((wave + 1) * nchunk) / 8;
    const int lrow = lane >> 3, lpc = lane & 7;
    for (int u = F.vcu; u < 256; u += F.G) {
        const int ct = 2 * (u >> 5) + (u & 1), rt = (u >> 1) & 15;
        const bf16* ap = A + (size_t)(MP + 32 * rt + lrow) * K + lpc * 8;
        const bf16* bp = Bt + (size_t)(64 * ct + lrow) * K + lpc * 8;
        f32x16 acc0 = f32x16{}, acc1 = f32x16{};
        v4u ra[4], rb[8], na[4], nb[8];
#define SK_LOAD(RA, RB, C) do { _Pragma("unroll") for (int i = 0; i < 4; ++i) RA[i] = *(const v4u*)(ap + (size_t)(8 * i) * K + (C) * 64); \
                                _Pragma("unroll") for (int i = 0; i < 8; ++i) RB[i] = *(const v4u*)(bp + (size_t)(8 * i) * K + (C) * 64); } while (0)
#define SK_STEP(RA, RB, NA, NB, C) do { if ((C) + 1 < c_hi) SK_LOAD(NA, NB, (C) + 1); \
            __builtin_amdgcn_sched_barrier(0); \
            _Pragma("unroll") for (int i = 0; i < 4; ++i) *(LAS v4u*)(AL + (8 * i + lrow) * 144 + lpc * 16) = RA[i]; \
            _Pragma("unroll") for (int i = 0; i < 8; ++i) *(LAS v4u*)(BL + (8 * i + lrow) * 144 + lpc * 16) = RB[i]; \
            asm volatile("s_waitcnt lgkmcnt(0)" ::: "memory"); \
            _Pragma("unroll") for (int ks = 0; ks < 4; ++ks) { const bf16x8 af = *(const LAS bf16x8*)(AL + r32 * 144 + ks * 32 + hi * 16); \
                const bf16x8 b0 = *(const LAS bf16x8*)(BL + r32 * 144 + ks * 32 + hi * 16), b1 = *(const LAS bf16x8*)(BL + (32 + r32) * 144 + ks * 32 + hi * 16); \
                acc0 = __builtin_amdgcn_mfma_f32_32x32x16_bf16(af, b0, acc0, 0, 0, 0); acc1 = __builtin_amdgcn_mfma_f32_32x32x16_bf16(af, b1, acc1, 0, 0, 0); } \
            asm volatile("s_waitcnt lgkmcnt(0)" ::: "memory"); } while (0)
        __syncthreads();
        SK_LOAD(ra, rb, c_lo);
#pragma unroll 1
        for (int c = c_lo; c < c_hi; c += 2) { SK_STEP(ra, rb, na, nb, c); if (c + 1 < c_hi) SK_STEP(na, nb, ra, rb, c + 1); }
#undef SK_LOAD
#undef SK_STEP
        __syncthreads();
#pragma unroll
        for (int r = 0; r < 16; ++r) { const int row = crow(r, hi); RL[(wave * 32 + row) * 68 + r32] = acc0[r]; RL[(wave * 32 + row) * 68 + 32 + r32] = acc1[r]; }
        __syncthreads();
        {
            const int row = tid >> 4, c4 = (tid & 15) * 4;
            f32x4 sum = *(const LAS f32x4*)(RL + row * 68 + c4);
#pragma unroll
            for (int w = 1; w < 8; ++w) sum = sum + *(const LAS f32x4*)(RL + (w * 32 + row) * 68 + c4);
            const size_t ro = (size_t)(MP + 32 * rt + row) * DM + 64 * ct + c4;
            const unsigned long long hb = *(const unsigned long long*)(HB + ro); const unsigned h0 = (unsigned)hb, h1 = (unsigned)(hb >> 32);
            f32x4 h; h.x = __builtin_bit_cast(float, h0 << 16) + sum.x; h.y = __builtin_bit_cast(float, h0 & 0xffff0000u) + sum.y; h.z = __builtin_bit_cast(float, h1 << 16) + sum.z; h.w = __builtin_bit_cast(float, h1 & 0xffff0000u) + sum.w;
            if (FINAL) *(f32x4*)(Y + ro) = h;
            else {
            *(unsigned long long*)(HB + ro) = (unsigned long long)pk2(h.x, h.y) | ((unsigned long long)pk2(h.z, h.w) << 32);
            float ss = (h.x * h.x + h.y * h.y) + (h.z * h.z + h.w * h.w);
            ss += __shfl_xor(ss, 1); ss += __shfl_xor(ss, 2); ss += __shfl_xor(ss, 4); ss += __shfl_xor(ss, 8);
            if ((tid & 15) == 0) SSQ[(size_t)(MP + 32 * rt + row) * 16 + ct] = ss; }
        }
    }
}


__device__ __forceinline__ void phase_wincopy(const Frame& F, const Args& a, int part, int nparts, int bidx, int nblk) {
    const f32x4* sw = (const f32x4*)a.in[I_SWIN]; f32x4* wo = (f32x4*)(a.out + O_WINS);
    const size_t NW = (size_t)128 * 508 * 128, per = (NW + nparts - 1) / nparts, lo = per * part, hi = (lo + per < NW) ? lo + per : NW;
    const size_t stride = (size_t)nblk * NTHR;
    for (size_t i0 = lo + (size_t)bidx * NTHR + F.tid; i0 < hi; i0 += 8 * stride) {
        f32x4 v[8];
#pragma unroll
        for (int k = 0; k < 8; ++k) { const size_t i = i0 + (size_t)k * stride; if (i < hi) { const size_t s = i / (508 * 128), r = i % (508 * 128); v[k] = __builtin_nontemporal_load(sw + (s * 512 * 128 + 4 * 128 + r)); } }
#pragma unroll
        for (int k = 0; k < 8; ++k) { const size_t i = i0 + (size_t)k * stride; if (i < hi) { const size_t s = i / (508 * 128), r = i % (508 * 128); __builtin_nontemporal_store(v[k], wo + (s * 512 * 128 + r)); } }
    }
}

#ifndef ATT_PROBE
#define ATT_PROBE
#endif
#ifndef ATT_RLO
#define ATT_RLO M
#endif
constexpr int NPH = 22;
#define KP ((KArgs)__builtin_amdgcn_kernarg_segment_ptr())
#define PH_BEGIN { const int id_ = ph++; if (lo <= id_ && id_ < hi) { Frame F; F.lds = lds_; F.wave = wv_; F.vcu = vcu_; F.G = G_; F.lane = pg8::hw_lane(); F.tid = wv_ * 64 + F.lane;
#define PH_END if (id_ + 1 < hi) xcd_barrier(bar); } }
#define FRESH_F(FN) Frame FN; FN.lds = lds_; FN.wave = wv_; FN.vcu = vcu_; FN.G = G_; FN.lane = pg8::hw_lane(); FN.tid = wv_ * 64 + FN.lane;
template <int l> __device__ __forceinline__ void run_layer(const int wv_, const int vcu_, const int G_, LAS unsigned char* lds_, const Args& args, const XcdBarrier& bar, int& ph, const int lo, const int hi) {
    unsigned char* ws = args.ws;
    float* H = args.out + O_Y;
    bf16* HB = (bf16*)(ws + WS_XN);
    float* SSQA = (float*)(ws + WS_SSQA); float* SSQB = (float*)(ws + WS_SSQB);
    if constexpr (l < 2) {
        PH_BEGIN { pg8::Gemm g{HB, (const bf16*)(ws + WS_WIN) + (size_t)l * 4096 * DM, M, 4096, DM, F.wave}; pg8::StaticOrder S; S.init(M, 4096, F.G, (int)blockIdx.x);
            EpiGelu E{KP}; pg8::gemm_phase<EpiGelu, pg8::StaticOrder, true, true>(F.lds, g, S, E);
            { if (F.G == 256) { if ((int)blockIdx.x >= 32) { __syncthreads(); FRESH_F(F3) phase_compress_fast(F3, args, 64 + 224 * l, 288 + 224 * l, (int)blockIdx.x - 32, 224); } }
              else { FRESH_F(F3) phase_wincopy(F3, args, l, 2, (int)blockIdx.x, F.G); } } } PH_END
        PH_BEGIN { phase_spatial_fast(F, args, l); __syncthreads(); FRESH_F(F2) phase_spatial_sample(F2, args, l); } PH_END
        PH_BEGIN { const bf16* A = (const bf16*)(ws + WS_GATED); const bf16* Bt = (const bf16*)(ws + WS_WOUTA) + (size_t)l * DM * DA;
            pg8::Gemm g{A, Bt, MP, DM, DA, F.wave}; pg8::StaticOrder S; S.init(MP, DM, F.G, (int)blockIdx.x);
            EpiResidT<false> E{KP, 0}; pg8::gemm_phase<EpiResidT<false>, pg8::StaticOrder, true, true>(F.lds, g, S, E);
            __syncthreads(); FRESH_F(F2) skinny_resid<false>(F2, A, Bt, DA, H, HB, SSQA); } PH_END
    } else {
        PH_BEGIN { constexpr int N = (l == 2) ? NKVQ : NQ3; pg8::Gemm g{HB, (const bf16*)(ws + (l == 2 ? WS_WKVQ : WS_WQ3)), M, N, DM, F.wave}; pg8::StaticOrder S; S.init(M, N, F.G, (int)blockIdx.x);
            EpiHead E{KP, l};
            pg8::gemm_phase<EpiHead, pg8::StaticOrder, true, true>(F.lds, g, S, E);
            if constexpr (l == 3) { if (F.G == 256 && (int)blockIdx.x >= 74) { FRESH_F(F3) phase_wincopy(F3, args, 1, 2, (int)blockIdx.x - 74, 182); } } } PH_END
        if constexpr (l == 2) { PH_BEGIN phase_compress_fast(F, args, 0, (F.G == 256) ? 64 : 680, F.vcu, F.G); PH_END }
        PH_BEGIN { phase_attn_prompt<0>(F, args, (bf16*)(ws + WS_O)); __syncthreads(); FRESH_F(F2) phase_attn_sample(F2, args); } PH_END
        PH_BEGIN { const bf16* A = (const bf16*)(ws + WS_O); const bf16* Bt = (const bf16*)(ws + WS_WOB) + (size_t)(l - 2) * DM * DM;
            pg8::Gemm g{A, Bt, MP, DM, DM, F.wave}; pg8::StaticOrder S; S.init(MP, DM, F.G, (int)blockIdx.x);
            EpiResidT<false> E{KP, 0}; pg8::gemm_phase<EpiResidT<false>, pg8::StaticOrder, true, true>(F.lds, g, S, E);
            __syncthreads(); FRESH_F(F2) skinny_resid<false>(F2, A, Bt, DM, H, HB, SSQA); } PH_END
    }
    PH_BEGIN { pg8::Gemm g{HB, (const bf16*)(ws + WS_WGU) + (size_t)l * 2 * DFF * DM, M, 2 * DFF, DM, F.wave}; pg8::StaticOrder S; S.init(M, 2 * DFF, F.G, (int)blockIdx.x);
        EpiSwiglu E{KP}; pg8::gemm_phase<EpiSwiglu, pg8::StaticOrder, true, true>(F.lds, g, S, E);
        if constexpr (l < 2) { if (F.G == 256 && (int)blockIdx.x >= 172) { __syncthreads(); FRESH_F(F3) phase_compress_fast(F3, args, 512 + 84 * l, 596 + 84 * l, (int)blockIdx.x - 172, 84); } }
        if constexpr (l == 2) { if (F.G == 256 && (int)blockIdx.x >= 172) { FRESH_F(F3) phase_wincopy(F3, args, 0, 2, (int)blockIdx.x - 172, 84); } } } PH_END
    PH_BEGIN { const bf16* A = (const bf16*)(ws + WS_ACT); const bf16* Bt = (const bf16*)(ws + WS_WD) + (size_t)l * DM * DFF;
        pg8::Gemm g{A, Bt, MP, DM, DFF, F.wave}; pg8::StaticOrder S; S.init(MP, DM, F.G, (int)blockIdx.x);
        EpiResidT<(l == 3)> E{KP, 1}; pg8::gemm_phase<EpiResidT<(l == 3)>, pg8::StaticOrder, true, true>(F.lds, g, S, E);
        __syncthreads(); FRESH_F(F2) skinny_resid<(l == 3)>(F2, A, Bt, DFF, H, HB, SSQB); } PH_END
}
__global__ void __launch_bounds__(NTHR, 2) yoco_fwd(Args args) {
    extern __shared__ __attribute__((aligned(16))) unsigned char lds[];
    LAS unsigned char* lds_ = (LAS unsigned char*)lds;
    const int wv_ = __builtin_amdgcn_readfirstlane((int)threadIdx.x >> 6), G_ = gridDim.x;
    int vcu_; { const int bx = blockIdx.x; vcu_ = (G_ % 8 == 0) ? (bx % 8) * (G_ / 8) + bx / 8 : bx; }
    volatile LAS unsigned* MISC = (volatile LAS unsigned*)(lds_ + MISC_OFF);
    for (int u = threadIdx.x; u < (LDS_BYTES - RING_BYTES) / 4; u += NTHR) ((LAS unsigned*)(lds_ + RING_BYTES))[u] = 0u;
    __syncthreads();
    const int lo = args.ph_lo, hi = args.ph_hi;
    const bool use_bar = (hi - lo) > 1;
    unsigned* barw = (unsigned*)(args.ws + WS_CTL) + CW_BAR + args.li * XCD_BAR_WORDS;
    XcdBarrier bar; bar.bar = barw; bar.x = 0; bar.st = nullptr; bar.wv = wv_;
    if (use_bar) { bar = xcd_barrier_post(barw, MISC + 8); bar.wv = wv_; }
    int ph = 0;
    PH_BEGIN phase_prologue(F, args); PH_END
    run_layer<0>(wv_, vcu_, G_, lds_, args, bar, ph, lo, hi);
    run_layer<1>(wv_, vcu_, G_, lds_, args, bar, ph, lo, hi);
    run_layer<2>(wv_, vcu_, G_, lds_, args, bar, ph, lo, hi);
    run_layer<3>(wv_, vcu_, G_, lds_, args, bar, ph, lo, hi);
}
#undef PH_BEGIN
#undef PH_END

#ifndef MK_SPLIT
#define MK_SPLIT 0
#endif
extern "C" void kernel_launch(void* const* d_in, const int* in_sizes, int n_in, void* d_out, int out_size, void* d_ws, size_t ws_size, hipStream_t stream) {
    static int grid = 0;
    if (grid == 0) {
        if (n_in != N_IN || (size_t)out_size != O_END || ws_size < WS_END) { fprintf(stderr, "kernel_launch: unexpected shapes (n_in %d out %d ws %zu)\n", n_in, out_size, ws_size); grid = -1; return; }
        int dev = 0, cus = 0, per_cu = 0;
        if (hipGetDevice(&dev) != hipSuccess || hipDeviceGetAttribute(&cus, hipDeviceAttributeMultiprocessorCount, dev) != hipSuccess) { grid = -1; return; }
        if (hipFuncSetAttribute((const void*)yoco_fwd, hipFuncAttributeMaxDynamicSharedMemorySize, LDS_BYTES) != hipSuccess) { fprintf(stderr, "kernel_launch: hipFuncSetAttribute failed\n"); grid = -1; return; }
        if (hipOccupancyMaxActiveBlocksPerMultiprocessor(&per_cu, (const void*)yoco_fwd, NTHR, LDS_BYTES) != hipSuccess || per_cu < 1) { fprintf(stderr, "kernel_launch: occupancy query says %d\n", per_cu); }
        (void)hipGetLastError();
        grid = cus;
    }
    if (grid < 0) return;
    if (hipMemsetAsync((char*)d_ws + WS_CTL, 0, CTL_ZERO_BYTES, stream) != hipSuccess) return;
    Args a{};
    for (int i = 0; i < N_IN; ++i) a.in[i] = d_in[i];
    a.out = (float*)d_out; a.ws = (unsigned char*)d_ws; a.pad = 0;
#if MK_SPLIT
    for (int p = 0; p < NPH; ++p) { a.ph_lo = p; a.ph_hi = p + 1; a.li = 0; hipLaunchKernelGGL(yoco_fwd, dim3(grid), dim3(NTHR), LDS_BYTES, stream, a); }
#else
    a.ph_lo = 0; a.ph_hi = NPH; a.li = 0; hipLaunchKernelGGL(yoco_fwd, dim3(grid), dim3(NTHR), LDS_BYTES, stream, a);
#endif
    const hipError_t le = hipPeekAtLastError();
    if (le != hipSuccess) fprintf(stderr, "kernel_launch: launch failed: %s\n", hipGetErrorName(le));
}
```

```cpp
#include <hip/hip_runtime.h>
#include <cstdio>
#include <cstdint>
#include <cmath>
namespace pg8 {
#define PG8_LAS __attribute__((address_space(3)))
typedef unsigned short bf16_t;
typedef short bf16x8 __attribute__((ext_vector_type(8)));
typedef float f32x4 __attribute__((ext_vector_type(4)));
typedef unsigned u32x4 __attribute__((ext_vector_type(4)));
constexpr int BM = 256, BK = 64, HALF = 128, HTB = HALF * BK * 2  , STAGE_BYTES = 8 * HTB, NXCD = 8, WGM = 8;

__host__ __device__ __forceinline__ int lds_byte(int r, int c) { const int st = (r >> 4) * 2 + (c >> 5), rr = r & 15, cc = c & 31, ob = rr * 64 + cc * 2; return st * 1024 + (ob ^ (((ob >> 9) & 1) << 5)); }
__host__ __device__ __forceinline__ void stage_rc(int b, int& R, int& C) { const int st = b / 1024, sb = b % 1024, swz = sb ^ (((sb >> 9) & 1) << 5); R = (st >> 1) * 16 + swz / 64; C = (st & 1) * 32 + (swz % 64) / 2; }
__host__ __device__ __forceinline__ int perm32(int rho) { const int n = rho >> 4, i = rho & 15; return 8 * (i >> 2) + 4 * n + (i & 3); }

struct Unit { int pm, pn; };
struct Gemm { const bf16_t* A; const bf16_t* Bt; int M, N, K, wave; };
__device__ __forceinline__ int hw_lane() { int l; asm volatile("v_mbcnt_lo_u32_b32 %0, -1, 0\n\tv_mbcnt_hi_u32_b32 %0, -1, %0" : "=v"(l)); return l; }

struct StaticOrder {
    int nM, nN, nwg, G, c;
    __host__ __device__ void init(int M, int N, int G_, int c_) { nM = M / BM; nN = N / BM; nwg = nM * nN; G = G_; c = c_; }
    __host__ __device__ bool next(int i, Unit& u) const {
        const long L = (long)i * G + c; if (L >= nwg) return false;
        int wgid = (int)L; { const int q = nwg / NXCD, r = nwg % NXCD, xcd = wgid % NXCD, off = wgid / NXCD; wgid = (xcd < r ? xcd * (q + 1) : r * (q + 1) + (xcd - r) * q) + off; }
        const int nig = WGM * nN, gid = wgid / nig, fm = gid * WGM, gsz = (nM - fm) < WGM ? (nM - fm) : WGM;
        u.pm = fm + ((wgid % nig) % gsz); u.pn = (wgid % nig) / gsz; return true;
    }
    __device__ __forceinline__ void a_ready(const Unit&) const {}
    __device__ __forceinline__ void done(const Unit&) const {}
};

__device__ __forceinline__ unsigned cvt_pk_bf16(float lo, float hi) { unsigned r; asm volatile("v_cvt_pk_bf16_f32 %0, %1, %2" : "=v"(r) : "v"(lo), "v"(hi)); return r; }
typedef float f32x2 __attribute__((ext_vector_type(2)));
__device__ __forceinline__ f32x2 gelu_pk(f32x2 v) {
    const f32x2 av = __builtin_elementwise_abs(v), d = av * 0.2316418882f + 1.0f;
    f32x2 t; t.x = __builtin_amdgcn_rcpf(d.x); t.y = __builtin_amdgcn_rcpf(d.y);
    f32x2 q = t * 0.5307027145f + (-0.7265760135f); q = q * t + 0.7107068705f; q = q * t + (-0.142248368f); q = q * t + 0.127414796f; q = q * t;
    const f32x2 s = (v * v) * (-0.72134752044f);
    f32x2 e; e.x = __builtin_amdgcn_exp2f(s.x); e.y = __builtin_amdgcn_exp2f(s.y);
    const f32x2 m = v * (q * e), r = v - m;
    f32x2 o; o.x = v.x < 0.f ? m.x : r.x; o.y = v.y < 0.f ? m.y : r.y; return o;
}

template <int ACT  > struct EpiBf16 {
    static constexpr bool PERM = true, AFTER_DRAIN = false; static_assert(ACT == 0 || ACT == 1, "EpiBf16: ACT is 0 (none) or 1 (gelu_pk)");
    bf16_t* O; int ldc; const float* bias; int split_cols; size_t split_stride; float scale0;
    __device__ __forceinline__ void operator()(const f32x4 (&acc)[2][2][4][2], const Unit& u, int wr, int wc, int fr, int fq) const {
        const int row0 = u.pm * BM + wr * 64 + fr; int colt = u.pn * BM; bf16_t* base = O;
        float sc = 1.f; if (split_cols) { const int t = colt / split_cols; base += (size_t)t * split_stride; colt -= t * split_cols; if (t == 0) sc = scale0; }
        const int col0 = colt + wc * 32 + 8 * fq, bcol0 = u.pn * BM + wc * 32 + 8 * fq;
        f32x4 bv[2][2];
#pragma unroll
        for (int bj = 0; bj < 2; ++bj)
#pragma unroll
            for (int n = 0; n < 2; ++n) bv[bj][n] = bias ? *(const f32x4*)(bias + bcol0 + bj * HALF + 4 * n) : (f32x4){0.f, 0.f, 0.f, 0.f};
#pragma unroll
        for (int ai = 0; ai < 2; ++ai)
#pragma unroll
            for (int m = 0; m < 4; ++m) { bf16_t* rowp = base + (size_t)(row0 + ai * HALF + m * 16) * ldc + col0;
#pragma unroll
                for (int bj = 0; bj < 2; ++bj) { f32x4 v0 = acc[ai][bj][m][0] + bv[bj][0], v1 = acc[ai][bj][m][1] + bv[bj][1];
                    if (ACT == 1) { f32x2 a = gelu_pk((f32x2){v0[0], v0[1]}), b = gelu_pk((f32x2){v0[2], v0[3]}), c = gelu_pk((f32x2){v1[0], v1[1]}), d = gelu_pk((f32x2){v1[2], v1[3]});
                        v0 = (f32x4){a.x, a.y, b.x, b.y}; v1 = (f32x4){c.x, c.y, d.x, d.y}; }
                    v0 = v0 * sc; v1 = v1 * sc; u32x4 w; w.x = cvt_pk_bf16(v0[0], v0[1]); w.y = cvt_pk_bf16(v0[2], v0[3]); w.z = cvt_pk_bf16(v1[0], v1[1]); w.w = cvt_pk_bf16(v1[2], v1[3]);
                    *(u32x4*)(rowp + bj * HALF) = w; } }
    }
};
template <class Epi, class Sched, bool ALIGN_EPI = false, bool SP2 = false>
__device__ __forceinline__ void gemm_phase(PG8_LAS unsigned char* lds, const Gemm g, const Sched& S, const Epi& E) {
    const int wid = g.wave, lane = hw_lane(), tid = wid * 64 + lane, wr = wid >> 2, wc = wid & 3, fr = lane & 15, fq = lane >> 4;
    const int K = g.K, nt = K / BK;
    unsigned voffA[2], voffB[2];
#pragma unroll
    for (int i = 0; i < 2; ++i) { int R, C; stage_rc(tid * 16 + i * 8192, R, C); const int Rb = Epi::PERM ? ((R & ~31) + perm32(R & 31)) : R;
        voffA[i] = (unsigned)(R * K + C) * 2u; voffB[i] = (unsigned)(Rb * K + C) * 2u; }
    const size_t kstep = (size_t)(BK * 2);
    const size_t hstep = (size_t)HALF * K * 2;
    const size_t tstep = 2 * hstep;
    const unsigned ldsw = (unsigned)wid * 1024u;
    const int aoff = lds_byte(wr * 64 + fr, fq * 8), boff = lds_byte(wc * 32 + fr, fq * 8);
#define PG8_SA(b, h) (((b) * 2 + (h)) * HTB)
#define PG8_SB(b, h) ((4 + (b) * 2 + (h)) * HTB)
#define PG8_STAGE(bufoff, gbase, voff) do { _Pragma("unroll") for (int _i = 0; _i < 2; ++_i) \
        __builtin_amdgcn_global_load_lds((const unsigned*)((const char*)(gbase) + (voff)[_i]), (PG8_LAS unsigned*)(lds + (bufoff) + ldsw + _i * 8192), 16, 0, 0); } while (0)
#define PG8_LDA(dst, b, h) do { _Pragma("unroll") for (int m = 0; m < 4; ++m) _Pragma("unroll") for (int k = 0; k < 2; ++k) dst[m][k] = *(const PG8_LAS bf16x8*)(lds + PG8_SA(b, h) + aoff + m * 2048 + k * 1024); } while (0)
#define PG8_LDB(dst, b, h) do { _Pragma("unroll") for (int n = 0; n < 2; ++n) _Pragma("unroll") for (int k = 0; k < 2; ++k) dst[n][k] = *(const PG8_LAS bf16x8*)(lds + PG8_SB(b, h) + boff + n * 2048 + k * 1024); } while (0)
#define PG8_MMA(ai, bj, At, Bt) do { __builtin_amdgcn_s_setprio(1); _Pragma("unroll") for (int m = 0; m < 4; ++m) _Pragma("unroll") for (int n = 0; n < 2; ++n) _Pragma("unroll") for (int k = 0; k < 2; ++k) \
        acc[ai][bj][m][n] = __builtin_amdgcn_mfma_f32_16x16x32_bf16(Bt[n][k], At[m][k], acc[ai][bj][m][n], 0, 0, 0); __builtin_amdgcn_s_setprio(0); } while (0)
#define PG8_WAIT_V(n) asm volatile("s_waitcnt vmcnt(" #n ")" ::: "memory")
#define PG8_WAIT_L(n) asm volatile("s_waitcnt lgkmcnt(" #n ")" ::: "memory")
#define PG8_BAR __builtin_amdgcn_s_barrier()
#define PG8_SCHED __builtin_amdgcn_sched_barrier(0)
    Unit cur, nxt; int ui = 0;
    if (!S.next(0, cur)) return;
    f32x4 acc[2][2][4][2];
#pragma unroll
    for (int a = 0; a < 2; ++a)
#pragma unroll
        for (int b = 0; b < 2; ++b)
#pragma unroll
            for (int m = 0; m < 4; ++m)
#pragma unroll
                for (int n = 0; n < 2; ++n) acc[a][b][m][n] = (f32x4){0.f, 0.f, 0.f, 0.f};
    bf16x8 At[4][2], B0[2][2], B1[2][2];
    const char* cA = (const char*)g.A + (size_t)cur.pm * tstep; const char* cB = (const char*)g.Bt + (size_t)cur.pn * tstep;
    S.a_ready(cur);
    if constexpr (SP2) {
        PG8_STAGE(PG8_SB(0, 0), cB, voffB); PG8_STAGE(PG8_SB(0, 1), cB + hstep, voffB); PG8_STAGE(PG8_SA(0, 0), cA, voffA); PG8_STAGE(PG8_SA(0, 1), cA + hstep, voffA);
        if (wr == 1) PG8_BAR;
        PG8_WAIT_V(2); PG8_BAR;
        PG8_STAGE(PG8_SB(1, 0), cB + kstep, voffB); PG8_STAGE(PG8_SA(1, 0), cA + kstep, voffA); PG8_STAGE(PG8_SB(1, 1), cB + hstep + kstep, voffB);
        PG8_WAIT_V(6); PG8_BAR;
    } else {
        PG8_STAGE(PG8_SB(0, 0), cB, voffB); PG8_STAGE(PG8_SA(0, 0), cA, voffA); PG8_STAGE(PG8_SB(0, 1), cB + hstep, voffB); PG8_STAGE(PG8_SA(0, 1), cA + hstep, voffA);
        if (wr == 1) PG8_BAR;
        PG8_WAIT_V(4); PG8_BAR;
        PG8_STAGE(PG8_SB(1, 0), cB + kstep, voffB); PG8_STAGE(PG8_SA(1, 0), cA + kstep, voffA); PG8_STAGE(PG8_SB(1, 1), cB + hstep + kstep, voffB);
        PG8_WAIT_V(6); PG8_BAR;
    }
    for (;;) {
        const bool has_next = S.next(ui + 1, nxt);
        const char* nA = has_next ? (const char*)g.A + (size_t)nxt.pm * tstep : cA; const char* nB = has_next ? (const char*)g.Bt + (size_t)nxt.pn * tstep : cB;
        for (int t = 0; t < nt; t += 2) {
            const bool last = (t == nt - 2);
            const char* a1 = cA + (size_t)(t + 1) * kstep;
            const char* a2 = last ? nA : cA + (size_t)(t + 2) * kstep; const char* b2 = last ? nB : cB + (size_t)(t + 2) * kstep;
            const char* a3 = a2 + kstep; const char* b3 = b2 + kstep;
            if (last && has_next) S.a_ready(nxt);
            if constexpr (SP2) {
            PG8_LDB(B0, 0, 0); PG8_LDB(B1, 0, 1); PG8_SCHED; PG8_LDA(At, 0, 0); PG8_STAGE(PG8_SA(1, 1), a1 + hstep, voffA);
            PG8_WAIT_V(8); PG8_WAIT_L(0); PG8_BAR; PG8_MMA(0, 0, At, B0); PG8_MMA(0, 1, At, B1); PG8_BAR; PG8_SCHED;
            PG8_LDA(At, 0, 1); PG8_STAGE(PG8_SB(0, 0), b2, voffB); PG8_STAGE(PG8_SB(0, 1), b2 + hstep, voffB); PG8_STAGE(PG8_SA(0, 0), a2, voffA);
            PG8_WAIT_V(8); PG8_WAIT_L(0); PG8_BAR; PG8_MMA(1, 0, At, B0); PG8_MMA(1, 1, At, B1); PG8_BAR; PG8_SCHED;
            PG8_LDB(B0, 1, 0); PG8_LDB(B1, 1, 1); PG8_SCHED; PG8_LDA(At, 1, 0); PG8_STAGE(PG8_SA(0, 1), a2 + hstep, voffA);
            PG8_WAIT_V(8); PG8_WAIT_L(0); PG8_BAR; PG8_MMA(0, 0, At, B0); PG8_MMA(0, 1, At, B1); PG8_BAR; PG8_SCHED;
            PG8_LDA(At, 1, 1); PG8_STAGE(PG8_SB(1, 0), b3, voffB); PG8_STAGE(PG8_SB(1, 1), b3 + hstep, voffB); PG8_STAGE(PG8_SA(1, 0), a3, voffA);
            PG8_WAIT_V(8); PG8_WAIT_L(0); PG8_BAR; PG8_MMA(1, 0, At, B0); PG8_MMA(1, 1, At, B1); PG8_BAR; PG8_SCHED;
            } else {
            PG8_LDB(B0, 0, 0); PG8_SCHED; PG8_LDA(At, 0, 0); PG8_STAGE(PG8_SA(1, 1), a1 + hstep, voffA);
            PG8_WAIT_L(8); PG8_BAR; PG8_WAIT_L(0); PG8_MMA(0, 0, At, B0); PG8_BAR; PG8_SCHED;
            PG8_LDB(B1, 0, 1); PG8_STAGE(PG8_SB(0, 0), b2, voffB);
            PG8_BAR; PG8_WAIT_L(0); PG8_MMA(0, 1, At, B1); PG8_BAR;
            PG8_LDA(At, 0, 1); PG8_STAGE(PG8_SA(0, 0), a2, voffA);
            PG8_BAR; PG8_WAIT_L(0); PG8_MMA(1, 0, At, B0); PG8_BAR; PG8_SCHED;
            PG8_STAGE(PG8_SB(0, 1), b2 + hstep, voffB);
            PG8_WAIT_V(6); PG8_BAR; PG8_MMA(1, 1, At, B1); PG8_BAR;
            PG8_LDB(B0, 1, 0); PG8_SCHED; PG8_LDA(At, 1, 0); PG8_STAGE(PG8_SA(0, 1), a2 + hstep, voffA);
            PG8_WAIT_L(8); PG8_BAR; PG8_WAIT_L(0); PG8_MMA(0, 0, At, B0); PG8_BAR; PG8_SCHED;
            PG8_LDB(B1, 1, 1); PG8_STAGE(PG8_SB(1, 0), b3, voffB);
            PG8_BAR; PG8_WAIT_L(0); PG8_MMA(0, 1, At, B1); PG8_BAR;
            PG8_LDA(At, 1, 1); PG8_STAGE(PG8_SA(1, 0), a3, voffA);
            PG8_BAR; PG8_WAIT_L(0); PG8_MMA(1, 0, At, B0); PG8_BAR; PG8_SCHED;
            PG8_STAGE(PG8_SB(1, 1), b3 + hstep, voffB);
            PG8_WAIT_V(6); PG8_BAR; PG8_MMA(1, 1, At, B1); PG8_BAR;
            }
        }
        if constexpr (ALIGN_EPI) { if (wr == 0) PG8_BAR; }
        if constexpr (!Epi::AFTER_DRAIN) { E(acc, cur, wr, wc, fr, fq); S.done(cur); }
        if (!has_next) break;
#pragma unroll
        for (int a = 0; a < 2; ++a)
#pragma unroll
            for (int b = 0; b < 2; ++b)
#pragma unroll
                for (int m = 0; m < 4; ++m)
#pragma unroll
                    for (int n = 0; n < 2; ++n) acc[a][b][m][n] = (f32x4){0.f, 0.f, 0.f, 0.f};
        cur = nxt; cA = nA; cB = nB; ++ui;
        if constexpr (ALIGN_EPI) { if (wr == 1) PG8_BAR; }
    }
    PG8_WAIT_V(0);
    if constexpr (!ALIGN_EPI) { if (wr == 0) PG8_BAR; }
    PG8_BAR;
    if constexpr (Epi::AFTER_DRAIN) { E.fused(acc, cur, wr, wc, fr, fq, lds, wid, lane); S.done(cur); }
#undef PG8_SA
#undef PG8_SB
#undef PG8_STAGE
#undef PG8_LDA
#undef PG8_LDB
#undef PG8_MMA
#undef PG8_WAIT_V
#undef PG8_WAIT_L
#undef PG8_BAR
#undef PG8_SCHED
}
}
#define GAS __attribute__((address_space(1)))
#define LAS __attribute__((address_space(3)))
typedef unsigned short bf16;
typedef unsigned v4u __attribute__((ext_vector_type(4)));
typedef float f32x4 __attribute__((ext_vector_type(4)));
typedef short bf16x8 __attribute__((ext_vector_type(8)));
typedef GAS unsigned gu32;
typedef GAS unsigned long long gu64;
#define RLX_AGENT __ATOMIC_RELAXED, __HIP_MEMORY_SCOPE_AGENT
#define LDS_WAIT() asm volatile("s_waitcnt lgkmcnt(0)" ::: "memory")
#define VM_WAIT() asm volatile("s_waitcnt vmcnt(0)" ::: "memory")
__device__ __forceinline__ unsigned long long rt() { return __builtin_amdgcn_s_memrealtime(); }
__device__ __forceinline__ unsigned f2bf(float f) { unsigned u = __builtin_bit_cast(unsigned, f); return (u + 0x7fffu + ((u >> 16) & 1u)) >> 16; }
__device__ __forceinline__ unsigned pk2(float lo, float hi) { return f2bf(lo) | (f2bf(hi) << 16); }
#define XB_TMO      128
#define XB_XCNT(j)  (256  + 64 * (j))
#define XB_XSUB(j)  (1280 + 64 * (j))
#define XB_XGEN(j)  (2304 + 64 * (j))
#define XB_TOP      3328
#define XB_TOPGEN   3392
#define XCD_BAR_WORDS 3456
#define XB_SPIN_CAP (1u << 18)

__device__ __forceinline__ unsigned xb_ld(unsigned* p)              { return __hip_atomic_load(p, __ATOMIC_RELAXED, __HIP_MEMORY_SCOPE_AGENT); }
__device__ __forceinline__ unsigned xb_add(unsigned* p, unsigned v) { return __hip_atomic_fetch_add(p, v, __ATOMIC_RELAXED, __HIP_MEMORY_SCOPE_AGENT); }
__device__ __forceinline__ unsigned xb_xcc_id() { return (unsigned)__builtin_amdgcn_s_getreg((3 << 11) | 20) & 0xFu; }
#define XB_SPIN(cond, bar) do { unsigned _sp = 0; while (cond) { __builtin_amdgcn_s_sleep(1); \
    if ((++_sp & 255u) == 0u) { if (xb_ld(&(bar)[XB_TMO])) break; if (_sp > XB_SPIN_CAP) { atomicAdd(&(bar)[XB_TMO], 1u); break; } } } } while (0)

struct XcdBarrier {
    unsigned* bar; unsigned x; int wv;
    volatile LAS unsigned* st;
};

__device__ __forceinline__ XcdBarrier xcd_barrier_post(unsigned* bar, volatile LAS unsigned* st) {
    XcdBarrier b; b.bar = bar; b.x = xb_xcc_id(); b.st = st;
    if (threadIdx.x == 0) (void)xb_add(&bar[XB_XCNT(b.x)], 1u);
    return b;
}
__device__ __forceinline__ void xcd_barrier_complete(unsigned* bar, unsigned x, unsigned& nloc, unsigned& nx) {
    const unsigned G = gridDim.x * gridDim.y * gridDim.z;
    unsigned sum, cnt, mine, sp = 0u;
    for (;;) {
        sum = 0u; cnt = 0u; mine = 0u;
#pragma unroll
        for (unsigned j = 0; j < 16; ++j) { const unsigned c = xb_ld(&bar[XB_XCNT(j)]); sum += c; cnt += (c > 0u) ? 1u : 0u; mine = (j == x) ? c : mine; }
        if (sum == G) break;
        __builtin_amdgcn_s_sleep(1);
        if ((++sp & 255u) == 0u) { if (xb_ld(&bar[XB_TMO])) break; if (sp > XB_SPIN_CAP) { atomicAdd(&bar[XB_TMO], 1u); break; } }
    }
    nloc = mine > 0u ? mine : 1u; nx = cnt > 0u ? cnt : 1u;
}

__device__ __forceinline__ void xcd_barrier(const XcdBarrier& b) {
    asm volatile("s_waitcnt vmcnt(0)" ::: "memory");
    __syncthreads();
    if (b.wv == 0 && pg8::hw_lane() == 0) {
        unsigned* bar = b.bar;
        __builtin_amdgcn_s_waitcnt(0);
        unsigned nloc = b.st[0], nx = b.st[1];
        if (nloc == 0u) { xcd_barrier_complete(bar, b.x, nloc, nx); b.st[0] = nloc; b.st[1] = nx; }
        const unsigned old = xb_add(&bar[XB_XSUB(b.x)], 1u);
        const unsigned gen = old / nloc;
        if (old + 1u == (gen + 1u) * nloc) {
            __builtin_amdgcn_fence(__ATOMIC_RELEASE, "agent");
            asm volatile("s_waitcnt vmcnt(0)" ::: "memory");
            const unsigned og = xb_add(&bar[XB_TOP], 1u);
            const unsigned tg = og / nx;
            if (og + 1u == (tg + 1u) * nx) xb_add(&bar[XB_TOPGEN], 1u);
            else XB_SPIN(xb_ld(&bar[XB_TOPGEN]) == tg, bar);
            __builtin_amdgcn_fence(__ATOMIC_ACQUIRE, "agent");
            xb_add(&bar[XB_XGEN(b.x)], 1u);
            asm volatile("s_waitcnt vmcnt(0)" ::: "memory");
        } else {
            XB_SPIN(xb_ld(&bar[XB_XGEN(b.x)]) == gen, bar);
            __builtin_amdgcn_fence(__ATOMIC_ACQUIRE, "agent");
            asm volatile("s_waitcnt vmcnt(0)" ::: "memory");
        }
    }
    __syncthreads();
}

constexpr int NWAVES = 8, NTHR = 512;
constexpr int MP = 16384, MS = 512, M = MP + MS;
constexpr int DM = 1024, DFF = 2816, DA = 2048, SEQ = 2048;
constexpr int NKVQ = 2816, NQ3 = 1280;
constexpr float EPS = 1e-6f;
constexpr size_t MiB = 1u << 20;

enum { I_XP = 0, I_XS, I_CCMP, I_CSLC, I_SWIN, I_PT, I_NMIX, I_NFFN, I_WG, I_WU, I_WD, I_AWIN, I_ALNG, I_ALNB, I_AWS, I_ABS, I_AWOUT,
       I_KVN, I_KVW, I_KNC, I_KNS, I_KNW, I_CPK, I_CPV, I_CWK, I_CWV, I_BWIN, I_BQN, I_BWOUT, N_IN };

constexpr size_t O_Y = 0;
constexpr size_t O_KVCMP = (size_t)M * DM;
constexpr size_t O_KVSLC = O_KVCMP + (size_t)M * 512;
constexpr size_t O_WINP = O_KVSLC + (size_t)M * 512;
constexpr size_t O_WINS = O_WINP + (size_t)8 * 512 * 512;
constexpr size_t O_AV = O_WINS + (size_t)128 * 512 * 512;
constexpr size_t O_END = O_AV + (size_t)2 * 128 * 4 * 2048;

constexpr size_t WS_CTL = 0, CTL_ZERO_BYTES = 1 * MiB;
constexpr size_t WS_WIN = 2 * MiB;
constexpr size_t WS_WOUTA = 18 * MiB;
constexpr size_t WS_WGU = 26 * MiB;
constexpr size_t WS_WD = 70 * MiB;
constexpr size_t WS_WKVQ = 92 * MiB;
constexpr size_t WS_WQ3 = 98 * MiB;
constexpr size_t WS_WOB = 101 * MiB;
constexpr size_t WS_XN = 112 * MiB;
constexpr size_t WS_UV = 146 * MiB;
constexpr size_t WS_GATED = 278 * MiB;
constexpr size_t WS_ACT = 344 * MiB;
constexpr size_t WS_PROJ = 435 * MiB;
constexpr size_t WS_O = 617 * MiB;
constexpr size_t WS_QN = 650 * MiB;
constexpr size_t WS_QR = 716 * MiB;
constexpr size_t WS_GATES = 782 * MiB;
constexpr size_t WS_KVWIN = 786 * MiB;
constexpr size_t WS_OC = 819 * MiB;
constexpr size_t WS_OS = 885 * MiB;
constexpr size_t WS_PCMP = 951 * MiB;
constexpr size_t WS_SCORE = 1083 * MiB;
constexpr size_t WS_SELM = 1094 * MiB;
constexpr size_t WS_KC = 1095 * MiB;
constexpr size_t WS_VC = 1112 * MiB;
constexpr size_t WS_LNST = 1129 * MiB;
constexpr size_t WS_QNB = 1131 * MiB;
constexpr size_t WS_QRB = 1164 * MiB;
constexpr size_t WS_KSB = 1197 * MiB;
constexpr size_t WS_VSB = 1205 * MiB;
constexpr size_t WS_KWB = 1213 * MiB;
constexpr size_t WS_VWB = 1221 * MiB;
constexpr size_t WS_KCB = 1229 * MiB;
constexpr size_t WS_VCB = 1238 * MiB;
constexpr size_t WS_CWT = 1247 * MiB;
constexpr size_t WS_CBIAS = 1248 * MiB;
constexpr size_t WS_SSQA = 1249 * MiB;
constexpr size_t WS_SSQB = 1251 * MiB;
constexpr size_t WS_ROPE = 1253 * MiB;
constexpr size_t WS_LNP = 1254 * MiB;
constexpr size_t WS_END = 1259 * MiB;

constexpr int CW_BAR = 4096;
constexpr int LDS_BYTES = 147456;
constexpr int RING_BYTES = 131072, MISC_OFF = LDS_BYTES - 128;

struct Args { const void* in[N_IN]; float* out; unsigned char* ws; int ph_lo, ph_hi, li, pad; };
typedef const __attribute__((address_space(4))) Args* KArgs;

struct Frame {
    LAS unsigned char* lds;
    int tid, lane, wave, vcu, G;
};

__device__ __forceinline__ float wave_sum(float v) {
#pragma unroll
    for (int o = 1; o < 64; o <<= 1) v += __shfl_xor(v, o);
    return v;
}
__device__ __forceinline__ float bf2f(unsigned short b) { return __builtin_bit_cast(float, (unsigned)b << 16); }

__device__ __forceinline__ float gelu_tanh(float x) {
    const float t = x * (1.0f + 0.044715f * x * x) * (-2.0f * 0.7978845608028654f * 1.4426950408889634f);
    return x * __builtin_amdgcn_rcpf(1.0f + __builtin_amdgcn_exp2f(t));
}
__device__ __forceinline__ float silu_f(float x) { return x * __builtin_amdgcn_rcpf(1.0f + __builtin_amdgcn_exp2f(-1.4426950408889634f * x)); }

__device__ __forceinline__ void row_rstd(const float* SSQ, int row0, float (&rs)[2][4], int fq) {
    pg8::f32x4 q[2][4];
#pragma unroll
    for (int ai = 0; ai < 2; ++ai)
#pragma unroll
        for (int m = 0; m < 4; ++m) q[ai][m] = *(const pg8::f32x4*)(SSQ + (size_t)(row0 + ai * 128 + m * 16) * 16 + 4 * fq);
#pragma unroll
    for (int ai = 0; ai < 2; ++ai)
#pragma unroll
        for (int m = 0; m < 4; ++m) { float t = (q[ai][m][0] + q[ai][m][1]) + (q[ai][m][2] + q[ai][m][3]);
            t += __shfl_xor(t, 16); t += __shfl_xor(t, 32);
            rs[ai][m] = 1.0f / sqrtf(t * (1.f / DM) + EPS); }
}
__device__ __forceinline__ float row_rstd1(const float* SSQ, int row) {
    const pg8::f32x4* p = (const pg8::f32x4*)(SSQ + (size_t)row * 16);
    const pg8::f32x4 a = p[0], b = p[1], c = p[2], d = p[3];
    const float t = ((a[0] + a[1]) + (a[2] + a[3])) + ((b[0] + b[1]) + (b[2] + b[3])) + ((c[0] + c[1]) + (c[2] + c[3])) + ((d[0] + d[1]) + (d[2] + d[3]));
    return 1.0f / sqrtf(t * (1.f / DM) + EPS);
}
struct EpiGelu {
    static constexpr bool PERM = true, AFTER_DRAIN = false;
    KArgs kp;
    __device__ __forceinline__ void operator()(const pg8::f32x4 (&acc)[2][2][4][2], const pg8::Unit& u, int wr, int wc, int fr, int fq) const {
        unsigned char* ws_ = kp->ws; bf16* O = (bf16*)(ws_ + WS_UV); constexpr int ldc = 4096; const float* SSQ = (const float*)(ws_ + WS_SSQB); float* LNP = (float*)(ws_ + WS_LNP);
        const int row0 = u.pm * 256 + wr * 64 + fr, col0 = u.pn * 256 + wc * 32 + 8 * fq;
        pg8::f32x4 qa;
        qa = *(const pg8::f32x4*)(SSQ + (size_t)row0 * 16 + 4 * fq);
#pragma unroll
        for (int ai = 0; ai < 2; ++ai)
#pragma unroll
            for (int m = 0; m < 4; ++m) { bf16* rowp = O + (size_t)(row0 + ai * 128 + m * 16) * ldc + col0;
                float tq = (qa[0] + qa[1]) + (qa[2] + qa[3]); tq += __shfl_xor(tq, 16); tq += __shfl_xor(tq, 32);
                const float r = 1.0f / sqrtf(tq * (1.f / DM) + EPS);
                if (ai * 4 + m < 7) { const int itn = ai * 4 + m + 1; qa = *(const pg8::f32x4*)(SSQ + (size_t)(row0 + (itn >> 2) * 128 + (itn & 3) * 16) * 16 + 4 * fq); }
                float sm = 0.f, sq = 0.f;
#pragma unroll
                for (int bj = 0; bj < 2; ++bj) { const pg8::f32x4 v0 = acc[ai][bj][m][0] * r, v1 = acc[ai][bj][m][1] * r;
                    float gv[8];
#pragma unroll
                    for (int i = 0; i < 4; ++i) { gv[i] = gelu_tanh(v0[i]); gv[4 + i] = gelu_tanh(v1[i]); }
#pragma unroll
                    for (int i = 0; i < 8; ++i) { sm += gv[i]; sq += gv[i] * gv[i]; }
                    v4u w; w.x = pg8::cvt_pk_bf16(gv[0], gv[1]); w.y = pg8::cvt_pk_bf16(gv[2], gv[3]); w.z = pg8::cvt_pk_bf16(gv[4], gv[5]); w.w = pg8::cvt_pk_bf16(gv[6], gv[7]);
                    *(v4u*)(rowp + bj * 128) = w; }
                if (u.pn >= 8) { sm += __shfl_xor(sm, 16); sm += __shfl_xor(sm, 32); sq += __shfl_xor(sq, 16); sq += __shfl_xor(sq, 32);
                    if (fq == 0) { float* lp = LNP + ((size_t)(row0 + ai * 128 + m * 16) * 32 + (u.pn - 8) * 4 + wc) * 2; lp[0] = sm; lp[1] = sq; } }
                asm volatile("" ::: "memory"); }
    }
};
struct EpiSwiglu {
    static constexpr bool PERM = true, AFTER_DRAIN = false;
    KArgs kp;
    __device__ __forceinline__ void operator()(const pg8::f32x4 (&acc)[2][2][4][2], const pg8::Unit& u, int wr, int wc, int fr, int fq) const {
        typedef unsigned u32x2v __attribute__((ext_vector_type(2)));
        unsigned char* ws_ = kp->ws; bf16* O = (bf16*)(ws_ + WS_ACT); constexpr int ldc = DFF; const float* SSQ = (const float*)(ws_ + WS_SSQA);
        const int row0 = u.pm * 256 + wr * 64 + fr, col0 = (u.pn * 256 + wc * 32 + 8 * fq) >> 1;
        float rs[2][4]; row_rstd(SSQ, row0, rs, fq);
#pragma unroll
        for (int ai = 0; ai < 2; ++ai)
#pragma unroll
            for (int m = 0; m < 4; ++m) { bf16* rowp = O + (size_t)(row0 + ai * 128 + m * 16) * ldc + col0; const float r = rs[ai][m];
#pragma unroll
                for (int bj = 0; bj < 2; ++bj) { const pg8::f32x4 g = acc[ai][bj][m][0] * r, up = acc[ai][bj][m][1] * r;
                    u32x2v w; w.x = pg8::cvt_pk_bf16(silu_f(g[0]) * up[0], silu_f(g[1]) * up[1]); w.y = pg8::cvt_pk_bf16(silu_f(g[2]) * up[2], silu_f(g[3]) * up[3]);
                    *(u32x2v*)(rowp + bj * 64) = w; } }
    }
};
template <bool FINAL> struct EpiResidT {
    static constexpr bool PERM = false, AFTER_DRAIN = false;
    KArgs kp; int sb;
    __device__ __forceinline__ void operator()(const pg8::f32x4 (&acc)[2][2][4][2], const pg8::Unit& u, int wr, int wc, int fr, int fq) const {
        typedef unsigned u32x2v __attribute__((ext_vector_type(2)));
        unsigned char* ws_ = kp->ws; float* Y = kp->out + O_Y; bf16* HB = (bf16*)(ws_ + WS_XN); float* SSQ = (float*)(ws_ + (sb ? WS_SSQB : WS_SSQA));
        const int row0 = u.pm * 256 + wr * 64 + fr, col0 = u.pn * 256 + wc * 32 + 4 * fq;
#pragma unroll
        for (int ai = 0; ai < 2; ++ai)
#pragma unroll
            for (int m = 0; m < 4; ++m) { const size_t ro = (size_t)(row0 + ai * 128 + m * 16) * DM + col0; float ss = 0.f;
#pragma unroll
                for (int bj = 0; bj < 2; ++bj)
#pragma unroll
                    for (int n = 0; n < 2; ++n) { u32x2v* p = (u32x2v*)(HB + ro + bj * 128 + n * 16); const u32x2v hb = *p;
                        pg8::f32x4 h; h[0] = __builtin_bit_cast(float, hb.x << 16); h[1] = __builtin_bit_cast(float, hb.x & 0xffff0000u); h[2] = __builtin_bit_cast(float, hb.y << 16); h[3] = __builtin_bit_cast(float, hb.y & 0xffff0000u);
                        h = h + acc[ai][bj][m][n];
                        if (FINAL) *(pg8::f32x4*)(Y + ro + bj * 128 + n * 16) = h;
                        else { ss += (h[0] * h[0] + h[1] * h[1]) + (h[2] * h[2] + h[3] * h[3]);
                            u32x2v w; w.x = pg8::cvt_pk_bf16(h[0], h[1]); w.y = pg8::cvt_pk_bf16(h[2], h[3]); *p = w; } }
                if (!FINAL) { ss += __shfl_xor(ss, 16); ss += __shfl_xor(ss, 32);
                    if (fq == 0) SSQ[(size_t)(row0 + ai * 128 + m * 16) * 16 + u.pn * 4 + wc] = ss; } }
    }
};
struct EpiRaw {
    static constexpr bool PERM = false, AFTER_DRAIN = false;
    float* P; int ldc; const float* SSQ;
    __device__ __forceinline__ void operator()(const pg8::f32x4 (&acc)[2][2][4][2], const pg8::Unit& u, int wr, int wc, int fr, int fq) const {
        const int row0 = u.pm * 256 + wr * 64 + fr, col0 = u.pn * 256 + wc * 32 + 4 * fq;
        float rs[2][4]; row_rstd(SSQ, row0, rs, fq);
#pragma unroll
        for (int ai = 0; ai < 2; ++ai)
#pragma unroll
            for (int m = 0; m < 4; ++m) { float* rowp = P + (size_t)(row0 + ai * 128 + m * 16) * ldc + col0;
#pragma unroll
                for (int bj = 0; bj < 2; ++bj)
#pragma unroll
                    for (int n = 0; n < 2; ++n) *(pg8::f32x4*)(rowp + bj * 128 + n * 16) = acc[ai][bj][m][n] * rs[ai][m]; }
    }
};

__device__ __forceinline__ void row_pos(int row, int& seq, int& pos) {
    if (row < MP) { seq = row >> 11; pos = row & 2047; } else { seq = 8 + ((row - MP) >> 2); pos = 2048 + ((row - MP) & 3); }
}

struct EpiHead {
    static constexpr bool PERM = false, AFTER_DRAIN = false;
    KArgs kp; int l;
    __device__ __forceinline__ void operator()(const pg8::f32x4 (&acc)[2][2][4][2], const pg8::Unit& u, int wr, int wc, int fr, int fq) const {
        typedef unsigned u32x2v __attribute__((ext_vector_type(2)));
        unsigned char* ws = kp->ws; float* out = kp->out; const float* SSQ = (const float*)(ws + WS_SSQB);
        const float* kns = (const float*)kp->in[I_KNS]; const float* knw = (const float*)kp->in[I_KNW]; const float* qnw = (const float*)kp->in[I_BQN] + (l - 2) * 64; const int nkv = (l == 2) ? 24 : 0;
        const int row0 = u.pm * 256 + wr * 64 + fr, slot = 4 * u.pn + wc;
        float rs[2][4]; row_rstd(SSQ, row0, rs, fq);
        const float* RT = (const float*)(ws + WS_ROPE);
        if (slot >= nkv + 16) {
            if (wc > 1) return;
            float* GA = (float*)(ws + WS_GATES);
#pragma unroll
            for (int ai = 0; ai < 2; ++ai)
#pragma unroll
                for (int m = 0; m < 4; ++m) { const int row = row0 + ai * 128 + m * 16; const float r = rs[ai][m];
#pragma unroll
                    for (int n = 0; n < 2; ++n) { if (wc == 1 && n == 1) continue; const pg8::f32x4 x = acc[ai][0][m][n] * r;
                        pg8::f32x4 o; o[0] = 1.0f / (1.0f + __expf(-x[0])); o[1] = 1.0f / (1.0f + __expf(-x[1])); o[2] = 1.0f / (1.0f + __expf(-x[2])); o[3] = 1.0f / (1.0f + __expf(-x[3]));
                        *(pg8::f32x4*)(GA + (size_t)row * 48 + 32 * wc + 16 * n + 4 * fq) = o; } }
            return;
        }
        const bool isq = slot >= nkv;
        const int br = slot >> 3, kvsel = (slot >> 2) & 1, g = slot & 3;
        const float* nw = isq ? qnw : (kvsel == 0 && br == 1) ? kns : (kvsel == 0 && br == 2) ? knw : nullptr;
        float nwv[2][2][4];
        if (nw) {
#pragma unroll
            for (int bj = 0; bj < 2; ++bj)
#pragma unroll
                for (int n = 0; n < 2; ++n) { const pg8::f32x4 t = *(const pg8::f32x4*)(nw + 32 * bj + 16 * n + 4 * fq); nwv[bj][n][0] = t[0]; nwv[bj][n][1] = t[1]; nwv[bj][n][2] = t[2]; nwv[bj][n][3] = t[3]; }
        }
        pg8::f32x4 pc01, pc23;
        if (nw) { int sq0, ps0; row_pos(row0, sq0, ps0); pc01 = *(const pg8::f32x4*)(RT + (size_t)ps0 * 16 + 8 * (fq & 1)); pc23 = *(const pg8::f32x4*)(RT + (size_t)ps0 * 16 + 8 * (fq & 1) + 4); }
#pragma unroll
        for (int ai = 0; ai < 2; ++ai)
#pragma unroll
            for (int m = 0; m < 4; ++m) {
                const int row = row0 + ai * 128 + m * 16; const float r = rs[ai][m];
                int seq, pos; row_pos(row, seq, pos);
                const pg8::f32x4 c01 = pc01, c23 = pc23;
                if (nw && (ai * 4 + m) < 7) { const int itn = ai * 4 + m + 1; int sqn, psn; row_pos(row0 + (itn >> 2) * 128 + (itn & 3) * 16, sqn, psn);
                    pc01 = *(const pg8::f32x4*)(RT + (size_t)psn * 16 + 8 * (fq & 1)); pc23 = *(const pg8::f32x4*)(RT + (size_t)psn * 16 + 8 * (fq & 1) + 4); }
                pg8::f32x4 x[2][2];
#pragma unroll
                for (int bj = 0; bj < 2; ++bj)
#pragma unroll
                    for (int n = 0; n < 2; ++n) x[bj][n] = acc[ai][bj][m][n] * r;
                if (nw) {
                    float ss = 0.f;
#pragma unroll
                    for (int bj = 0; bj < 2; ++bj)
#pragma unroll
                        for (int n = 0; n < 2; ++n) ss += (x[bj][n][0] * x[bj][n][0] + x[bj][n][1] * x[bj][n][1]) + (x[bj][n][2] * x[bj][n][2] + x[bj][n][3] * x[bj][n][3]);
                    ss += __shfl_xor(ss, 16); ss += __shfl_xor(ss, 32);
                    const float hr = 1.0f / sqrtf(ss * (1.f / 64) + EPS);
#pragma unroll
                    for (int bj = 0; bj < 2; ++bj)
#pragma unroll
                        for (int n = 0; n < 2; ++n)
#pragma unroll
                            for (int i = 0; i < 4; ++i) x[bj][n][i] = x[bj][n][i] * hr * nwv[bj][n][i];
                }
                if (isq) {
                    bf16* qb = (bf16*)(ws + WS_QNB) + (size_t)row * DM + (slot - nkv) * 64 + 4 * fq;
#pragma unroll
                    for (int bj = 0; bj < 2; ++bj)
#pragma unroll
                        for (int n = 0; n < 2; ++n) { u32x2v w; w.x = pg8::cvt_pk_bf16(x[bj][n][0], x[bj][n][1]); w.y = pg8::cvt_pk_bf16(x[bj][n][2], x[bj][n][3]); *(u32x2v*)(qb + 32 * bj + 16 * n) = w; }
                }
                if (nw) {
                    const float cs[4] = {c01[0], c01[2], c23[0], c23[2]}, sn[4] = {c01[1], c01[3], c23[1], c23[3]};
#pragma unroll
                    for (int i = 0; i < 4; ++i) { const float mine = x[0][0][i], oth = __shfl_xor(mine, 32);
                        x[0][0][i] = (fq < 2) ? mine * cs[i] - oth * sn[i] : mine * cs[i] + oth * sn[i]; }
                }
                float* f1 = nullptr; float* f2 = nullptr; bf16* b1 = nullptr;
                if (isq) b1 = (bf16*)(ws + WS_QRB) + (size_t)row * DM + (slot - nkv) * 64;
                else {
                    const int off = kvsel * 256 + g * 64;
                    if (br == 0) f1 = out + O_KVCMP + (size_t)row * 512 + off;
                    else if (br == 1) { f1 = out + O_KVSLC + (size_t)row * 512 + off; if (row < MP) b1 = (bf16*)(ws + (kvsel ? WS_VSB : WS_KSB)) + (((size_t)seq * 4 + g) * SEQ + pos) * 64; }
                    else { if (row >= MP) f1 = (float*)(ws + WS_KVWIN) + (size_t)row * 512 + off;
                        if (row < MP) { b1 = (bf16*)(ws + (kvsel ? WS_VWB : WS_KWB)) + (((size_t)seq * 4 + g) * SEQ + pos) * 64; if (pos >= SEQ - 512) f2 = out + O_WINP + ((size_t)seq * 512 + (pos - (SEQ - 512))) * 512 + off; }
                        else f2 = out + O_WINS + ((size_t)(seq - 8) * 512 + 508 + (pos - 2048)) * 512 + off; }
                }
#pragma unroll
                for (int bj = 0; bj < 2; ++bj)
#pragma unroll
                    for (int n = 0; n < 2; ++n) { const int d = 32 * bj + 16 * n + 4 * fq;
                        if (f1) *(pg8::f32x4*)(f1 + d) = x[bj][n];
                        if (f2) *(pg8::f32x4*)(f2 + d) = x[bj][n];
                        if (b1) { u32x2v w; w.x = pg8::cvt_pk_bf16(x[bj][n][0], x[bj][n][1]); w.y = pg8::cvt_pk_bf16(x[bj][n][2], x[bj][n][3]); *(u32x2v*)(b1 + d) = w; } }
            }
    }
};

__device__ __forceinline__ void rope_cs(int pos, int i, float& c, float& s) {
    const double inv[8] = {1.0, 0.19392274474868576, 0.03760603093086393, 0.007292664737217109, 0.001414213562373095, 0.0002742481756762073, 5.318295896944988e-05, 1.031338537721246e-05};
    double f = inv[0];
#pragma unroll
    for (int k = 1; k < 8; ++k) f = (i == k) ? inv[k] : f;
    const double ang = (double)pos * f; const double n = __builtin_rint(ang * 0.15915494309189535); const float r = (float)(ang - n * 6.283185307179586);
    c = cosf(r); s = sinf(r);
}
struct WJob { const float* src; const float* src2; const float* gain; const float* gain2; bf16* dst; int Nsrc, Nsrc2, K, Nphys, kind; };
struct WSrc { const float* p; const float* gain; int col, N; };
__device__ __forceinline__ WSrc wmap(const WJob& j, int p) {
    WSrc s; s.p = j.src; s.gain = j.gain; s.N = j.Nsrc; s.col = p;
    if (j.kind == 1) { const int w = p & 7; s.col = (p >> 3) * 4 + (w & 3); if (w >= 4) s.p = j.src2; }
    else if (j.kind == 2 || j.kind == 3) {
        const int ti = p >> 8, q = p & 255, wc = (q & 127) >> 5, d = 32 * (q >> 7) + (q & 31), head = 4 * ti + wc;
        const int nkv = (j.kind == 2) ? 24 : 0;
        if (head < nkv) { s.col = 64 * head + d; }
        else if (head < nkv + 16) { s.col = 64 * (head - nkv) + d; if (j.kind == 2) { s.p = j.src2; s.gain = j.gain2; s.N = j.Nsrc2; } }
        else { if (j.kind == 2) { s.p = j.src2; s.gain = j.gain2; s.N = j.Nsrc2; } s.col = (q < 48) ? 1024 + q : -1; }
    }
    return s;
}
__device__ __forceinline__ void conv_item(const WJob& j, int item, LAS float* scr, int lane) {
    const int nblk = j.Nphys / 32, kb = item / nblk, nb = item % nblk, k0 = 64 * kb, p0 = 32 * nb;
    const int p4 = (lane & 7) * 4, kr = lane >> 3;
    const WSrc s = wmap(j, p0 + p4);
#pragma unroll
    for (int i = 0; i < 8; ++i) { const int kk = 8 * i + kr; f32x4 v = (f32x4){0.f, 0.f, 0.f, 0.f};
        if (s.col >= 0) { v = __builtin_nontemporal_load((const f32x4*)(s.p + (size_t)(k0 + kk) * s.N + s.col)); if (s.gain) v = v * s.gain[k0 + kk]; }
        LAS float* d = scr + kk * 33 + p4; d[0] = v.x; d[1] = v.y; d[2] = v.z; d[3] = v.w; }
    asm volatile("s_waitcnt lgkmcnt(0)" ::: "memory");
    const int c = lane & 7;
#pragma unroll
    for (int jj = 0; jj < 4; ++jj) { const int n = (lane >> 3) + 8 * jj; const LAS float* sp = scr + (8 * c) * 33 + n;
        v4u o; o.x = pk2(sp[0 * 33], sp[1 * 33]); o.y = pk2(sp[2 * 33], sp[3 * 33]); o.z = pk2(sp[4 * 33], sp[5 * 33]); o.w = pk2(sp[6 * 33], sp[7 * 33]);
        if (j.kind == 4) {
            const int e2 = j.Nsrc2 * 64 + p0 + n, k = k0 + 8 * c, ll = k >> 6, hh = (k >> 5) & 1, sx = (k >> 3) & 3;
            *(GAS v4u*)(j.dst + ((size_t)(((ll * 4 + sx) * 4 + (e2 >> 5)) * 64 + hh * 32 + (e2 & 31))) * 8) = o;
        } else
        *(GAS v4u*)(j.dst + (size_t)(p0 + n) * j.K + k0 + 8 * c) = o; }
    asm volatile("s_waitcnt lgkmcnt(0)" ::: "memory");
}
constexpr int NJOBS = 20;
__device__ __forceinline__ WJob get_job(const Args& a, int j) {
    const float* const* in = (const float* const*)a.in; unsigned char* ws = a.ws;
    WJob w; w.src2 = nullptr; w.gain = nullptr; w.gain2 = nullptr; w.Nsrc2 = 0; w.kind = 0;
    if (j < 2)       { const int l = j;      w.src = in[I_AWIN] + (size_t)l * DM * 4096; w.gain = in[I_NMIX] + l * DM; w.dst = (bf16*)(ws + WS_WIN) + (size_t)l * 4096 * DM; w.Nsrc = 4096; w.K = DM; w.Nphys = 4096; }
    else if (j < 4)  { const int l = j - 2;  w.src = in[I_AWOUT] + (size_t)l * DA * DM; w.dst = (bf16*)(ws + WS_WOUTA) + (size_t)l * DM * DA; w.Nsrc = DM; w.K = DA; w.Nphys = DM; }
    else if (j < 8)  { const int l = j - 4;  w.src = in[I_WG] + (size_t)l * DM * DFF; w.src2 = in[I_WU] + (size_t)l * DM * DFF; w.gain = in[I_NFFN] + l * DM; w.dst = (bf16*)(ws + WS_WGU) + (size_t)l * 2 * DFF * DM; w.Nsrc = DFF; w.K = DM; w.Nphys = 2 * DFF; w.kind = 1; }
    else if (j < 12) { const int l = j - 8;  w.src = in[I_WD] + (size_t)l * DFF * DM; w.dst = (bf16*)(ws + WS_WD) + (size_t)l * DM * DFF; w.Nsrc = DM; w.K = DFF; w.Nphys = DM; }
    else if (j == 12) { w.src = in[I_KVW]; w.gain = in[I_KVN]; w.Nsrc = 1536; w.src2 = in[I_BWIN]; w.gain2 = in[I_NMIX] + 2 * DM; w.Nsrc2 = 1072; w.dst = (bf16*)(ws + WS_WKVQ); w.K = DM; w.Nphys = NKVQ; w.kind = 2; }
    else if (j == 13) { w.src = in[I_BWIN] + (size_t)DM * 1072; w.gain = in[I_NMIX] + 3 * DM; w.Nsrc = 1072; w.dst = (bf16*)(ws + WS_WQ3); w.K = DM; w.Nphys = NQ3; w.kind = 3; }
    else if (j < 16) { const int l = j - 14; w.src = in[I_BWOUT] + (size_t)l * DM * DM; w.dst = (bf16*)(ws + WS_WOB) + (size_t)l * DM * DM; w.Nsrc = DM; w.K = DM; w.Nphys = DM; }
    else { const int kv = (j - 16) >> 1, half = (j - 16) & 1; w.src = in[kv ? I_CWV : I_CWK] + (size_t)half * 1024 * 64; w.dst = (bf16*)(ws + WS_CWT) + (size_t)kv * 128 * 1024; w.Nsrc = 64; w.Nsrc2 = half; w.K = 1024; w.Nphys = 64; w.kind = 4; }
    return w;
}
__device__ __forceinline__ int job_items(int j) { return j < 2 ? 2048 : j < 4 ? 1024 : j < 8 ? 2816 : j < 13 ? 1408 : j == 13 ? 640 : j < 16 ? 512 : 32; }
__device__ __forceinline__ bool conv_locate(const Args& a, int g, WJob& w, int& it) {
    int j = 0;
    for (; j < NJOBS; ++j) { const int n = job_items(j); if (g < n) break; g -= n; }
    if (j >= NJOBS) return false;
    w = get_job(a, j); it = g; return true;
}
__device__ __forceinline__ void conv_load(const WJob& j, int item, int lane, f32x4 (&v)[8], float (&gn)[8]) {
    const int nblk = j.Nphys / 32, kb = item / nblk, nb = item % nblk, k0 = 64 * kb, p0 = 32 * nb;
    const int p4 = (lane & 7) * 4, kr = lane >> 3;
    const WSrc s = wmap(j, p0 + p4);
#pragma unroll
    for (int i = 0; i < 8; ++i) { const int kk = 8 * i + kr; v[i] = (f32x4){0.f, 0.f, 0.f, 0.f}; gn[i] = 1.f;
        if (s.col >= 0) { v[i] = __builtin_nontemporal_load((const f32x4*)(s.p + (size_t)(k0 + kk) * s.N + s.col)); if (s.gain) gn[i] = s.gain[k0 + kk]; } }
}
__device__ __forceinline__ void conv_store(const WJob& j, int item, int lane, LAS float* scr, const f32x4 (&v)[8], const float (&gn)[8]) {
    const int nblk = j.Nphys / 32, kb = item / nblk, nb = item % nblk, k0 = 64 * kb, p0 = 32 * nb;
    const int p4 = (lane & 7) * 4, kr = lane >> 3;
#pragma unroll
    for (int i = 0; i < 8; ++i) { const int kk = 8 * i + kr; const f32x4 x = v[i] * gn[i];
        LAS float* d = scr + kk * 33 + p4; d[0] = x.x; d[1] = x.y; d[2] = x.z; d[3] = x.w; }
    asm volatile("s_waitcnt lgkmcnt(0)" ::: "memory");
    const int c = lane & 7;
#pragma unroll
    for (int jj = 0; jj < 4; ++jj) { const int n = (lane >> 3) + 8 * jj; const LAS float* sp = scr + (8 * c) * 33 + n;
        v4u o; o.x = pk2(sp[0 * 33], sp[1 * 33]); o.y = pk2(sp[2 * 33], sp[3 * 33]); o.z = pk2(sp[4 * 33], sp[5 * 33]); o.w = pk2(sp[6 * 33], sp[7 * 33]);
        if (j.kind == 4) {
            const int e2 = j.Nsrc2 * 64 + p0 + n, k = k0 + 8 * c, ll = k >> 6, hh = (k >> 5) & 1, sx = (k >> 3) & 3;
            *(GAS v4u*)(j.dst + ((size_t)(((ll * 4 + sx) * 4 + (e2 >> 5)) * 64 + hh * 32 + (e2 & 31))) * 8) = o;
        } else
        *(GAS v4u*)(j.dst + (size_t)(p0 + n) * j.K + k0 + 8 * c) = o; }
    asm volatile("s_waitcnt lgkmcnt(0)" ::: "memory");
}
__device__ __forceinline__ void phase_prologue(const Frame& F, const Args& a) {
    LAS float* scr = (LAS float*)(F.lds + F.wave * 16384);
    const int gw = F.vcu * NWAVES + F.wave, NGW = F.G * NWAVES;
    {
        int g = gw; WJob wa, wb; int ia = 0, ib = 0; f32x4 A[8], B[8]; float ga[8], gb[8];
        bool va = conv_locate(a, g, wa, ia), vb = false;
        if (va) conv_load(wa, ia, F.lane, A, ga);
        while (va) {
            g += NGW; vb = conv_locate(a, g, wb, ib);
            if (vb) conv_load(wb, ib, F.lane, B, gb);
            __builtin_amdgcn_sched_barrier(0);
            conv_store(wa, ia, F.lane, scr, A, ga);
            if (!vb) break;
            g += NGW; va = conv_locate(a, g, wa, ia);
            if (va) conv_load(wa, ia, F.lane, A, ga);
            __builtin_amdgcn_sched_barrier(0);
            conv_store(wb, ib, F.lane, scr, B, gb);
        }
    }
    for (int i = F.vcu * NTHR + F.tid; i < 2052 * 8; i += F.G * NTHR) { float c, sn; rope_cs(i >> 3, i & 7, c, sn); ((float*)(a.ws + WS_ROPE))[2 * i] = c; ((float*)(a.ws + WS_ROPE))[2 * i + 1] = sn; }
    for (int o = gw; o < 128; o += NGW) { const int kv = o >> 6, e = o & 63; const float* pw = (const float*)a.in[kv ? I_CPV : I_CPK]; const float* ww = (const float*)a.in[kv ? I_CWV : I_CWK];
        float acc = 0.f; for (int i = F.lane; i < 2048; i += 64) acc += pw[i] * ww[(size_t)i * 64 + e];
        acc = wave_sum(acc); if (F.lane == 0) ((float*)(a.ws + WS_CBIAS))[o] = acc; }
    for (int m = gw; m < M; m += 2 * NGW) {
        const int m2 = (m + NGW < M) ? m + NGW : m;
        const f32x4* xr = (const f32x4*)((m < MP) ? (const float*)a.in[I_XP] + (size_t)m * DM : (const float*)a.in[I_XS] + (size_t)(m - MP) * DM) + F.lane;
        const f32x4* xq = (const f32x4*)((m2 < MP) ? (const float*)a.in[I_XP] + (size_t)m2 * DM : (const float*)a.in[I_XS] + (size_t)(m2 - MP) * DM) + F.lane;
        f32x4 v[4], w[4];
#pragma unroll
        for (int j = 0; j < 4; ++j) v[j] = __builtin_nontemporal_load(xr + 64 * j);
#pragma unroll
        for (int j = 0; j < 4; ++j) w[j] = __builtin_nontemporal_load(xq + 64 * j);
        __builtin_amdgcn_sched_barrier(0);
        {   unsigned long long* o8 = (unsigned long long*)((bf16*)(a.ws + WS_XN) + (size_t)m * DM) + F.lane;
            float ss = 0.f;
#pragma unroll
            for (int j = 0; j < 4; ++j) { ss += (v[j].x * v[j].x + v[j].y * v[j].y) + (v[j].z * v[j].z + v[j].w * v[j].w);
                o8[64 * j] = (unsigned long long)pk2(v[j].x, v[j].y) | ((unsigned long long)pk2(v[j].z, v[j].w) << 32); }
            ss = wave_sum(ss);
            if (F.lane < 16) ((float*)(a.ws + WS_SSQB))[(size_t)m * 16 + F.lane] = (F.lane == 0) ? ss : 0.f; }
        if (m2 != m) {
            unsigned long long* o8 = (unsigned long long*)((bf16*)(a.ws + WS_XN) + (size_t)m2 * DM) + F.lane;
            float ss = 0.f;
#pragma unroll
            for (int j = 0; j < 4; ++j) { ss += (w[j].x * w[j].x + w[j].y * w[j].y) + (w[j].z * w[j].z + w[j].w * w[j].w);
                o8[64 * j] = (unsigned long long)pk2(w[j].x, w[j].y) | ((unsigned long long)pk2(w[j].z, w[j].w) << 32); }
            ss = wave_sum(ss);
            if (F.lane < 16) ((float*)(a.ws + WS_SSQB))[(size_t)m2 * 16 + F.lane] = (F.lane == 0) ? ss : 0.f; }
    }
    const int gt = F.vcu * NTHR + F.tid, NGT = F.G * NTHR;
}

__device__ __forceinline__ void phase_norm(const Frame& F, const float* H, bf16* XN) {
    const int gw = F.vcu * NWAVES + F.wave, NGW = F.G * NWAVES;
    for (int m = gw; m < M; m += NGW) {
        const f32x4* xr = (const f32x4*)(H + (size_t)m * DM) + F.lane;
        f32x4 v[4]; float s = 0.f;
#pragma unroll
        for (int j = 0; j < 4; ++j) { v[j] = xr[64 * j]; s += (v[j].x * v[j].x + v[j].y * v[j].y) + (v[j].z * v[j].z + v[j].w * v[j].w); }
        const float rstd = 1.0f / sqrtf(wave_sum(s) * (1.f / DM) + EPS);
        unsigned long long* o8 = (unsigned long long*)(XN + (size_t)m * DM) + F.lane;
#pragma unroll
        for (int j = 0; j < 4; ++j) o8[64 * j] = (unsigned long long)pk2(v[j].x * rstd, v[j].y * rstd) | ((unsigned long long)pk2(v[j].z * rstd, v[j].w * rstd) << 32);
    }
}
__device__ __forceinline__ void phase_lnstat(const Frame& F, const bf16* UV, float* LNST) {
    const int gw = F.vcu * NWAVES + F.wave, NGW = F.G * NWAVES;
    for (int m = gw; m < M; m += NGW) {
        const v4u* vr = (const v4u*)(UV + (size_t)m * 4096 + 2048) + F.lane;
        float x[32]; float s = 0.f;
#pragma unroll
        for (int j = 0; j < 4; ++j) { const v4u w = vr[64 * j];
#pragma unroll
            for (int e = 0; e < 4; ++e) { const unsigned ww = w[e]; x[8 * j + 2 * e] = __builtin_bit_cast(float, ww << 16); x[8 * j + 2 * e + 1] = __builtin_bit_cast(float, ww & 0xffff0000u); } }
#pragma unroll
        for (int i = 0; i < 32; ++i) s += x[i];
        const float mean = wave_sum(s) * (1.f / DA); float q = 0.f;
#pragma unroll
        for (int i = 0; i < 32; ++i) { const float d = x[i] - mean; q += d * d; }
        const float rstd = 1.0f / sqrtf(wave_sum(q) * (1.f / DA) + EPS);
        if (F.lane == 0) { LNST[2 * m] = mean; LNST[2 * m + 1] = rstd; }
    }
}
__device__ __forceinline__ void phase_spatial_naive(const Frame& F, const Args& a, int l, const int rlo) {
    const bf16* UV = (const bf16*)(a.ws + WS_UV); const float* LNST = (const float*)(a.ws + WS_LNST); bf16* GT = (bf16*)(a.ws + WS_GATED);
    const float* lng = (const float*)a.in[I_ALNG] + l * DA; const float* lnb = (const float*)a.in[I_ALNB] + l * DA;
    const float* ws = (const float*)a.in[I_AWS] + (size_t)l * 8 * 128 * 128; const float* bs = (const float*)a.in[I_ABS] + l * 8 * 128;
    float* av = a.out + O_AV + (size_t)l * 128 * 4 * DA;
    const int gt = F.vcu * NTHR + F.tid, NGT = F.G * NTHR;
    for (size_t it = (size_t)rlo * 256 + gt; it < (size_t)M * 256; it += NGT) {
        const int row = (int)(it >> 8), c = (int)(it & 255) * 8, g = c >> 8;
        const int tt = (row < MP) ? (row & 127) : ((row - MP) & 3), r0 = row - tt;
        float gg[8], bb[8], acc[8];
#pragma unroll
        for (int i = 0; i < 8; ++i) { gg[i] = lng[c + i]; bb[i] = lnb[c + i]; acc[i] = 0.f; }
        const float* wrow = ws + ((size_t)g * 128 + tt) * 128;
        float own[8];
        for (int s = 0; s <= tt; ++s) {
            const float w = wrow[s], mean = LNST[2 * (r0 + s)], rstd = LNST[2 * (r0 + s) + 1];
            const v4u vv = *(const v4u*)(UV + (size_t)(r0 + s) * 4096 + 2048 + c);
#pragma unroll
            for (int e = 0; e < 4; ++e) { const unsigned ww = vv[e];
                const float v0 = (__builtin_bit_cast(float, ww << 16) - mean) * rstd * gg[2 * e] + bb[2 * e];
                const float v1 = (__builtin_bit_cast(float, ww & 0xffff0000u) - mean) * rstd * gg[2 * e + 1] + bb[2 * e + 1];
                acc[2 * e] += w * v0; acc[2 * e + 1] += w * v1; own[2 * e] = v0; own[2 * e + 1] = v1; }
        }
        const float bst = bs[g * 128 + tt];
        const v4u uu = *(const v4u*)(UV + (size_t)row * 4096 + c);
        v4u o;
#pragma unroll
        for (int e = 0; e < 4; ++e) { const unsigned ww = uu[e];
            o[e] = pk2(__builtin_bit_cast(float, ww << 16) * (acc[2 * e] + bst), __builtin_bit_cast(float, ww & 0xffff0000u) * (acc[2 * e + 1] + bst)); }
        *(v4u*)(GT + (size_t)row * DA + c) = o;
        if (row >= MP) { float* ap = av + (size_t)(row - MP) * DA + c; *(f32x4*)ap = (f32x4){own[0], own[1], own[2], own[3]}; *(f32x4*)(ap + 4) = (f32x4){own[4], own[5], own[6], own[7]}; }
    }
}

__device__ __forceinline__ void phase_post_naive(const Frame& F, const Args& a, int l) {
    const int ldp = (l == 2) ? NKVQ : NQ3, nkv = (l == 2) ? 24 : 0, nslot = nkv + 17;
    const float* P = (const float*)(a.ws + WS_PROJ);
    float* QN = (float*)(a.ws + WS_QN); float* QR = (float*)(a.ws + WS_QR); float* GA = (float*)(a.ws + WS_GATES); float* KVW = (float*)(a.ws + WS_KVWIN);
    const float* qnw = (const float*)a.in[I_BQN] + (l - 2) * 64;
    const int gt = F.vcu * NTHR + F.tid, NGT = F.G * NTHR;
    for (size_t it = gt; it < (size_t)M * nslot; it += NGT) {
        const int row = (int)(it / nslot), slot = (int)(it % nslot);
        int seq, pos; row_pos(row, seq, pos);
        const float* pr = P + (size_t)row * ldp;
        if (slot == nkv + 16) {
            const float* gp = pr + (nkv / 4 + 4) * 256;
            for (int i = 0; i < 48; ++i) GA[(size_t)row * 48 + i] = 1.0f / (1.0f + expf(-gp[i]));
            continue;
        }
        const int ti = slot >> 2, wc = slot & 3;
        float x[64];
#pragma unroll
        for (int i = 0; i < 16; ++i) { const int d = 4 * i; const f32x4 v = *(const f32x4*)(pr + ti * 256 + 128 * (d >> 5) + 32 * wc + (d & 31)); x[d] = v.x; x[d + 1] = v.y; x[d + 2] = v.z; x[d + 3] = v.w; }
        const float* nw = nullptr; bool do_rope = false; float* dst = nullptr; float* dst2 = nullptr; float* dst3 = nullptr; bf16* bdst = nullptr;
        if (slot < nkv) {
            const int br = slot >> 3, kvsel = (slot >> 2) & 1, g = slot & 3; const int off = kvsel * 256 + g * 64;
            if (br >= 1 && row < MP) bdst = (bf16*)(a.ws + (br == 1 ? (kvsel ? WS_VSB : WS_KSB) : (kvsel ? WS_VWB : WS_KWB))) + (((size_t)seq * 4 + g) * SEQ + pos) * 64;
            if (br == 0) dst = a.out + O_KVCMP + (size_t)row * 512 + off;
            else if (br == 1) { dst = a.out + O_KVSLC + (size_t)row * 512 + off; if (!kvsel) { nw = (const float*)a.in[I_KNS]; do_rope = true; } }
            else { dst = KVW + (size_t)row * 512 + off; if (!kvsel) { nw = (const float*)a.in[I_KNW]; do_rope = true; }
                if (row < MP) { if (pos >= SEQ - 512) dst2 = a.out + O_WINP + ((size_t)seq * 512 + (pos - (SEQ - 512))) * 512 + off; }
                else dst2 = a.out + O_WINS + ((size_t)(seq - 8) * 512 + 508 + (pos - 2048)) * 512 + off; }
        } else { const int h = slot - nkv; nw = qnw; dst = QN + (size_t)row * DM + h * 64; dst3 = QR + (size_t)row * DM + h * 64; do_rope = true; }
        if (nw) { float ss = 0.f;
#pragma unroll
            for (int d = 0; d < 64; ++d) ss += x[d] * x[d];
            const float rs = 1.0f / sqrtf(ss * (1.f / 64) + EPS);
#pragma unroll
            for (int d = 0; d < 64; ++d) x[d] = x[d] * rs * nw[d]; }
        if (dst3) {
#pragma unroll
            for (int i = 0; i < 16; ++i) *(f32x4*)(dst + 4 * i) = (f32x4){x[4 * i], x[4 * i + 1], x[4 * i + 2], x[4 * i + 3]};
            bf16* qb = (bf16*)(a.ws + WS_QNB) + (size_t)row * DM + (slot - nkv) * 64;
#pragma unroll
            for (int i = 0; i < 8; ++i) { v4u w; w.x = pk2(x[8 * i], x[8 * i + 1]); w.y = pk2(x[8 * i + 2], x[8 * i + 3]); w.z = pk2(x[8 * i + 4], x[8 * i + 5]); w.w = pk2(x[8 * i + 6], x[8 * i + 7]); *(v4u*)(qb + 8 * i) = w; }
            dst = dst3; bdst = (bf16*)(a.ws + WS_QRB) + (size_t)row * DM + (slot - nkv) * 64;
        }
        if (do_rope) {
#pragma unroll
            for (int i = 0; i < 8; ++i) { float c, s; rope_cs(pos, i, c, s); const float x1 = x[i], x2 = x[8 + i]; x[i] = x1 * c - x2 * s; x[8 + i] = x2 * c + x1 * s; }
        }
#pragma unroll
        for (int i = 0; i < 16; ++i) { const f32x4 v = (f32x4){x[4 * i], x[4 * i + 1], x[4 * i + 2], x[4 * i + 3]}; *(f32x4*)(dst + 4 * i) = v; if (dst2) *(f32x4*)(dst2 + 4 * i) = v; }
        if (bdst) {
#pragma unroll
            for (int i = 0; i < 8; ++i) { v4u w; w.x = pk2(x[8 * i], x[8 * i + 1]); w.y = pk2(x[8 * i + 2], x[8 * i + 3]); w.z = pk2(x[8 * i + 4], x[8 * i + 5]); w.w = pk2(x[8 * i + 6], x[8 * i + 7]); *(v4u*)(bdst + 8 * i) = w; }
        }
    }
}
__device__ __forceinline__ void phase_compress_naive(const Frame& F, const Args& a) {
    const int gw = F.vcu * NWAVES + F.wave, NGW = F.G * NWAVES, e = F.lane;
    const int* pt = (const int*)a.in[I_PT]; const float* cc = (const float*)a.in[I_CCMP];
    const float* knc = (const float*)a.in[I_KNC];
    for (int it = gw; it < 136 * 127 * 4 * 2; it += NGW) {
        const int which = it & 1, g = (it >> 1) & 3, n = (it >> 3) % 127, seq = (it >> 3) / 127;
        const float* w = (const float*)a.in[which ? I_CWV : I_CWK]; const float* posw = (const float*)a.in[which ? I_CPV : I_CPK];
        float acc = 0.f;
        for (int ll = 0; ll < 32; ++ll) {
            const int r = 16 * n + ll; const float* rp;
            if (seq < 8) rp = a.out + O_KVCMP + ((size_t)seq * SEQ + r) * 512;
            else rp = cc + ((size_t)pt[(seq - 8) * 16 + (r >> 7)] * 128 + (r & 127)) * 512;
            const float x = rp[which * 256 + g * 64 + e] + posw[ll * 64 + e];
            const float* wl = w + (size_t)ll * 4096 + e;
#pragma unroll
            for (int d = 0; d < 64; ++d) acc += __builtin_bit_cast(float, __builtin_amdgcn_readlane(__builtin_bit_cast(int, x), d)) * wl[d * 64];
        }
        float* dst = (float*)(a.ws + (which ? WS_VC : WS_KC)) + (((size_t)seq * 127 + n) * 4 + g) * 64;
        if (!which) { const float ss = wave_sum(acc * acc); acc = acc * (1.0f / sqrtf(ss * (1.f / 64) + EPS)) * knc[e]; }
        dst[e] = acc;
        bf16* bd = (bf16*)(a.ws + (which ? WS_VCB : WS_KCB)) + (((size_t)seq * 4 + g) * 128 + n) * 64;
        bd[e] = (bf16)f2bf(acc);
        if (n == 126) bd[64 + e] = 0;
    }
}
__device__ __forceinline__ void load64(const float* p, float (&q)[64]) {
#pragma unroll
    for (int i = 0; i < 16; ++i) { const f32x4 v = *(const f32x4*)(p + 4 * i); q[4 * i] = v.x; q[4 * i + 1] = v.y; q[4 * i + 2] = v.z; q[4 * i + 3] = v.w; }
}
__device__ __forceinline__ float dot64(const float (&q)[64], const float* k) {
    float s0 = 0.f, s1 = 0.f, s2 = 0.f, s3 = 0.f;
#pragma unroll
    for (int i = 0; i < 16; ++i) { const f32x4 v = *(const f32x4*)(k + 4 * i); s0 += q[4 * i] * v.x; s1 += q[4 * i + 1] * v.y; s2 += q[4 * i + 2] * v.z; s3 += q[4 * i + 3] * v.w; }
    return (s0 + s1) + (s2 + s3);
}
__device__ __forceinline__ void axpy64(float (&o)[64], float p, const float* v) {
#pragma unroll
    for (int i = 0; i < 16; ++i) { const f32x4 x = *(const f32x4*)(v + 4 * i); o[4 * i] += p * x.x; o[4 * i + 1] += p * x.y; o[4 * i + 2] += p * x.z; o[4 * i + 3] += p * x.w; }
}
__device__ __forceinline__ void phase_acmp_naive(const Frame& F, const Args& a, const int rlo) {
    const float* QN = (const float*)(a.ws + WS_QN); const float* KC = (const float*)(a.ws + WS_KC); const float* VC = (const float*)(a.ws + WS_VC);
    float* PC = (float*)(a.ws + WS_PCMP); float* OC = (float*)(a.ws + WS_OC);
    const int gt = F.vcu * NTHR + F.tid, NGT = F.G * NTHR;
    for (size_t it = (size_t)rlo * 16 + gt; it < (size_t)M * 16; it += NGT) {
        const int row = (int)(it >> 4), head = (int)(it & 15), g = head >> 2;
        int seq, pos; row_pos(row, seq, pos);
        float q[64]; load64(QN + (size_t)row * DM + head * 64, q);
        float* pc = PC + ((size_t)row * 16 + head) * 128;
        const int nv = (pos >= 31) ? min(127, (pos - 31) / 16 + 1) : 0;
        float m = -INFINITY;
        for (int n = 0; n < nv; ++n) { const float s = dot64(q, KC + (((size_t)seq * 127 + n) * 4 + g) * 64) * 0.125f; pc[n] = s; m = fmaxf(m, s); }
        float lsum = 0.f;
        for (int n = 0; n < nv; ++n) lsum += expf(pc[n] - m);
        const float inv = 1.0f / fmaxf(lsum, 1e-30f);
        float o[64];
#pragma unroll
        for (int d = 0; d < 64; ++d) o[d] = 0.f;
        for (int n = 0; n < nv; ++n) { const float p = expf(pc[n] - m) * inv; pc[n] = p; axpy64(o, p, VC + (((size_t)seq * 127 + n) * 4 + g) * 64); }
        for (int n = nv; n < 128; ++n) pc[n] = 0.f;
        float* op = OC + (size_t)row * DM + head * 64;
#pragma unroll
        for (int i = 0; i < 16; ++i) *(f32x4*)(op + 4 * i) = (f32x4){o[4 * i], o[4 * i + 1], o[4 * i + 2], o[4 * i + 3]};
    }
}
__device__ __forceinline__ void phase_asel_naive(const Frame& F, const Args& a, const int rlo) {
    const float* PC = (const float*)(a.ws + WS_PCMP); float* SC = (float*)(a.ws + WS_SCORE); unsigned long long* SM = (unsigned long long*)(a.ws + WS_SELM);
    const int gt = F.vcu * NTHR + F.tid, NGT = F.G * NTHR;
    for (size_t it = (size_t)rlo * 4 + gt; it < (size_t)M * 4; it += NGT) {
        const int row = (int)(it >> 2), g = (int)(it & 3);
        int seq, pos; row_pos(row, seq, pos);
        const int nsel = (row < MP) ? 32 : 33, cur = pos >> 6;
        float* sc = SC + (size_t)it * 40;
        const float* pc = PC + ((size_t)row * 16 + g * 4) * 128;
        for (int j = 0; j < nsel; ++j) {
            float imp = 0.f;
            for (int n = max(0, 4 * j - 1); n <= min(126, 4 * j + 3); ++n) imp += (pc[n] + pc[128 + n]) + (pc[256 + n] + pc[384 + n]);
            const bool forced = (j == 0) || (j == cur) || (j == cur - 1), valid = j <= cur;
            sc[j] = forced ? INFINITY : (valid ? imp : -INFINITY);
        }
        unsigned long long mask = 0ull;
        for (int j = 0; j < nsel; ++j) { const float sj = sc[j]; int rank = 0;
            for (int i = 0; i < nsel; ++i) { const float si = sc[i]; rank += (si > sj || (si == sj && i < j)) ? 1 : 0; }
            if (rank < 16 && sj > -INFINITY) mask |= 1ull << j; }
        SM[it] = mask;
    }
}
__device__ __forceinline__ void phase_aslc_naive(const Frame& F, const Args& a, const int rlo) {
    const float* QR = (const float*)(a.ws + WS_QR); const unsigned long long* SM = (const unsigned long long*)(a.ws + WS_SELM); float* OS = (float*)(a.ws + WS_OS);
    const float* KVS = a.out + O_KVSLC; const float* cs = (const float*)a.in[I_CSLC]; const int* pt = (const int*)a.in[I_PT];
    const int gt = F.vcu * NTHR + F.tid, NGT = F.G * NTHR;
    for (size_t it = (size_t)rlo * 16 + gt; it < (size_t)M * 16; it += NGT) {
        const int row = (int)(it >> 4), head = (int)(it & 15), g = head >> 2;
        int seq, pos; row_pos(row, seq, pos);
        float q[64]; load64(QR + (size_t)row * DM + head * 64, q);
        const unsigned long long mask = SM[(size_t)row * 4 + g];
        const int nsel = (row < MP) ? 32 : 33;
        float m = -INFINITY, lsum = 0.f, o[64];
#pragma unroll
        for (int d = 0; d < 64; ++d) o[d] = 0.f;
        for (int j = 0; j < nsel; ++j) {
            if (!((mask >> j) & 1ull)) continue;
            for (int kk = 0; kk < 64; ++kk) {
                const int key = 64 * j + kk; if (key > pos) break;
                const float* kp;
                if (row < MP) kp = KVS + ((size_t)seq * SEQ + key) * 512 + g * 64;
                else if (key < 2048) kp = cs + ((size_t)pt[(seq - 8) * 16 + (key >> 7)] * 128 + (key & 127)) * 512 + g * 64;
                else kp = KVS + ((size_t)MP + (seq - 8) * 4 + (key - 2048)) * 512 + g * 64;
                const float s = dot64(q, kp) * 0.125f;
                if (s > m) { const float f = expf(m - s); lsum *= f;
#pragma unroll
                    for (int d = 0; d < 64; ++d) o[d] *= f;
                    m = s; }
                const float p = expf(s - m); lsum += p; axpy64(o, p, kp + 256);
            }
        }
        const float inv = 1.0f / fmaxf(lsum, 1e-30f);
        float* op = OS + (size_t)row * DM + head * 64;
#pragma unroll
        for (int i = 0; i < 16; ++i) *(f32x4*)(op + 4 * i) = (f32x4){o[4 * i] * inv, o[4 * i + 1] * inv, o[4 * i + 2] * inv, o[4 * i + 3] * inv};
    }
}
__device__ __forceinline__ void phase_awin_naive(const Frame& F, const Args& a, const int rlo) {
    const float* QR = (const float*)(a.ws + WS_QR); const float* OC = (const float*)(a.ws + WS_OC); const float* OS = (const float*)(a.ws + WS_OS);
    const float* GA = (const float*)(a.ws + WS_GATES); const float* KVW = (const float*)(a.ws + WS_KVWIN); const float* sw = (const float*)a.in[I_SWIN];
    bf16* O = (bf16*)(a.ws + WS_O);
    const int gt = F.vcu * NTHR + F.tid, NGT = F.G * NTHR;
    for (size_t it = (size_t)rlo * 16 + gt; it < (size_t)M * 16; it += NGT) {
        const int row = (int)(it >> 4), head = (int)(it & 15), g = head >> 2;
        int seq, pos; row_pos(row, seq, pos);
        float q[64]; load64(QR + (size_t)row * DM + head * 64, q);
        float m = -INFINITY, lsum = 0.f, o[64];
#pragma unroll
        for (int d = 0; d < 64; ++d) o[d] = 0.f;
        for (int key = max(0, pos - 511); key <= pos; ++key) {
            const float* kp;
            if (row < MP) kp = KVW + ((size_t)seq * SEQ + key) * 512 + g * 64;
            else if (key < 2048) kp = sw + ((size_t)(seq - 8) * 512 + (key - 1536)) * 512 + g * 64;
            else kp = KVW + ((size_t)MP + (seq - 8) * 4 + (key - 2048)) * 512 + g * 64;
            const float s = dot64(q, kp) * 0.125f;
            if (s > m) { const float f = expf(m - s); lsum *= f;
#pragma unroll
                for (int d = 0; d < 64; ++d) o[d] *= f;
                m = s; }
            const float p = expf(s - m); lsum += p; axpy64(o, p, kp + 256);
        }
        const float inv = 1.0f / fmaxf(lsum, 1e-30f);
        const float g0 = GA[(size_t)row * 48 + head * 3], g1 = GA[(size_t)row * 48 + head * 3 + 1], g2 = GA[(size_t)row * 48 + head * 3 + 2] * inv;
        const float* oc = OC + (size_t)row * DM + head * 64; const float* os = OS + (size_t)row * DM + head * 64;
        bf16* op = O + (size_t)row * DM + head * 64;
#pragma unroll
        for (int i = 0; i < 8; ++i) { const f32x4 c0 = *(const f32x4*)(oc + 8 * i), c1 = *(const f32x4*)(oc + 8 * i + 4), s0 = *(const f32x4*)(os + 8 * i), s1 = *(const f32x4*)(os + 8 * i + 4);
            v4u w;
            w.x = pk2(g0 * c0.x + g1 * s0.x + g2 * o[8 * i], g0 * c0.y + g1 * s0.y + g2 * o[8 * i + 1]);
            w.y = pk2(g0 * c0.z + g1 * s0.z + g2 * o[8 * i + 2], g0 * c0.w + g1 * s0.w + g2 * o[8 * i + 3]);
            w.z = pk2(g0 * c1.x + g1 * s1.x + g2 * o[8 * i + 4], g0 * c1.y + g1 * s1.y + g2 * o[8 * i + 5]);
            w.w = pk2(g0 * c1.z + g1 * s1.z + g2 * o[8 * i + 6], g0 * c1.w + g1 * s1.w + g2 * o[8 * i + 7]);
            *(v4u*)(op + 8 * i) = w; }
    }
}


namespace fa {
typedef short bf16x8 __attribute__((ext_vector_type(8)));
typedef short s16x4 __attribute__((ext_vector_type(4)));
typedef float f32x16 __attribute__((ext_vector_type(16)));
typedef LAS const char* lcp;
constexpr float C2 = 0.125f * 1.4426950408889634f;
__device__ __forceinline__ int crow(int r, int hi) { return (r & 3) + 8 * (r >> 2) + 4 * hi; }
__device__ __forceinline__ s16x4 vtr(lcp p) { return __builtin_bit_cast(s16x4, __builtin_amdgcn_ds_read_tr16_b64_v4i16((LAS s16x4*)p)); }
__device__ __forceinline__ float max3f(float a, float b, float c) { return __builtin_fmaxf(__builtin_fmaxf(a, b), c); }
__device__ __forceinline__ float swapmax(float m) { auto rr = __builtin_amdgcn_permlane32_swap(__float_as_uint(m), __float_as_uint(m), false, false); return fmaxf(__uint_as_float(rr[0]), __uint_as_float(rr[1])); }
__device__ __forceinline__ float swapsum(float m) { auto rr = __builtin_amdgcn_permlane32_swap(__float_as_uint(m), __float_as_uint(m), false, false); return __uint_as_float(rr[0]) + __uint_as_float(rr[1]); }
struct St { f32x16 o0, o1; float m, l; };
__device__ __forceinline__ void st_reset(St& S) { S.o0 = f32x16{}; S.o1 = f32x16{}; S.m = -INFINITY; S.l = 0.f; }
__device__ __forceinline__ void qkt(f32x16& p0, f32x16& p1, lcp Kt, const bf16x8 (&qr)[4], int r32, int hi) {
    lcp kb = Kt + hi * 1024 + r32 * 16;
    p0 = f32x16{}; p1 = f32x16{};
#pragma unroll
    for (int ks = 0; ks < 4; ++ks) {
        const bf16x8 b0 = *(LAS const bf16x8*)(kb + ks * 2048), b1 = *(LAS const bf16x8*)(kb + ks * 2048 + 512);
        p0 = __builtin_amdgcn_mfma_f32_32x32x16_bf16(b0, qr[ks], p0, 0, 0, 0);
        p1 = __builtin_amdgcn_mfma_f32_32x32x16_bf16(b1, qr[ks], p1, 0, 0, 0);
    }
}
__device__ __forceinline__ unsigned cvtpk(float lo, float hi) { return pg8::cvt_pk_bf16(lo, hi); }
__device__ __forceinline__ void pv_tile(f32x16& o0, f32x16& o1, lcp Vt, const f32x16& p0, const f32x16& p1, int lane) {
    const int hi = lane >> 5;
    bf16x8 pa[4];
#pragma unroll
    for (int k = 0; k < 2; ++k) {
        v4u w0, w1;
        w0.x = cvtpk(p0[8 * k], p0[8 * k + 1]); w0.y = cvtpk(p0[8 * k + 2], p0[8 * k + 3]); w0.z = cvtpk(p0[8 * k + 4], p0[8 * k + 5]); w0.w = cvtpk(p0[8 * k + 6], p0[8 * k + 7]);
        w1.x = cvtpk(p1[8 * k], p1[8 * k + 1]); w1.y = cvtpk(p1[8 * k + 2], p1[8 * k + 3]); w1.z = cvtpk(p1[8 * k + 4], p1[8 * k + 5]); w1.w = cvtpk(p1[8 * k + 6], p1[8 * k + 7]);
        pa[k] = __builtin_bit_cast(bf16x8, w0); pa[2 + k] = __builtin_bit_cast(bf16x8, w1);
    }
    lcp vb = Vt + ((lane >> 4) & 1) * 32 + (lane & 3) * 8 + (4 * hi + ((lane & 15) >> 2)) * 64;
#pragma unroll
    for (int ks = 0; ks < 4; ++ks) {
        const s16x4 a0 = vtr(vb + ks * 1024), a1 = vtr(vb + ks * 1024 + 512), b0 = vtr(vb + 4096 + ks * 1024), b1 = vtr(vb + 4096 + ks * 1024 + 512);
        const bf16x8 v0 = (bf16x8){a0[0], a0[1], a0[2], a0[3], a1[0], a1[1], a1[2], a1[3]}, v1 = (bf16x8){b0[0], b0[1], b0[2], b0[3], b1[0], b1[1], b1[2], b1[3]};
        o0 = __builtin_amdgcn_mfma_f32_32x32x16_bf16(pa[ks], v0, o0, 0, 0, 0);
        o1 = __builtin_amdgcn_mfma_f32_32x32x16_bf16(pa[ks], v1, o1, 0, 0, 0);
    }
}
struct VFr { s16x4 a[4][2], b[4][2]; };
__device__ __forceinline__ void v_read(VFr& V, lcp Vt, int lane) {
    const int hi = lane >> 5;
    lcp vb = Vt + ((lane >> 4) & 1) * 32 + (lane & 3) * 8 + (4 * hi + ((lane & 15) >> 2)) * 64;
#pragma unroll
    for (int ks = 0; ks < 4; ++ks) { V.a[ks][0] = vtr(vb + ks * 1024); V.a[ks][1] = vtr(vb + ks * 1024 + 512); V.b[ks][0] = vtr(vb + 4096 + ks * 1024); V.b[ks][1] = vtr(vb + 4096 + ks * 1024 + 512); }
}
__device__ __forceinline__ void pv_frags(f32x16& o0, f32x16& o1, const VFr& V, const f32x16& p0, const f32x16& p1) {
    bf16x8 pa[4];
#pragma unroll
    for (int k = 0; k < 2; ++k) {
        v4u w0, w1;
        w0.x = cvtpk(p0[8 * k], p0[8 * k + 1]); w0.y = cvtpk(p0[8 * k + 2], p0[8 * k + 3]); w0.z = cvtpk(p0[8 * k + 4], p0[8 * k + 5]); w0.w = cvtpk(p0[8 * k + 6], p0[8 * k + 7]);
        w1.x = cvtpk(p1[8 * k], p1[8 * k + 1]); w1.y = cvtpk(p1[8 * k + 2], p1[8 * k + 3]); w1.z = cvtpk(p1[8 * k + 4], p1[8 * k + 5]); w1.w = cvtpk(p1[8 * k + 6], p1[8 * k + 7]);
        pa[k] = __builtin_bit_cast(bf16x8, w0); pa[2 + k] = __builtin_bit_cast(bf16x8, w1);
    }
#pragma unroll
    for (int ks = 0; ks < 4; ++ks) {
        const bf16x8 v0 = (bf16x8){V.a[ks][0][0], V.a[ks][0][1], V.a[ks][0][2], V.a[ks][0][3], V.a[ks][1][0], V.a[ks][1][1], V.a[ks][1][2], V.a[ks][1][3]};
        const bf16x8 v1 = (bf16x8){V.b[ks][0][0], V.b[ks][0][1], V.b[ks][0][2], V.b[ks][0][3], V.b[ks][1][0], V.b[ks][1][1], V.b[ks][1][2], V.b[ks][1][3]};
        o0 = __builtin_amdgcn_mfma_f32_32x32x16_bf16(pa[ks], v0, o0, 0, 0, 0);
        o1 = __builtin_amdgcn_mfma_f32_32x32x16_bf16(pa[ks], v1, o1, 0, 0, 0);
    }
}
__device__ __forceinline__ void tile_step(St& S, lcp Kt, lcp Vt, const bf16x8 (&qr)[4], bool rowon, bool EM, int lo, int hin, LAS float* wsf, int lane) {
    const int r32 = lane & 31, hi = lane >> 5;
    f32x16 p0, p1; qkt(p0, p1, Kt, qr, r32, hi);
    VFr VF; v_read(VF, Vt, lane);
    __builtin_amdgcn_sched_barrier(0);
    if (EM) {
        const int lo2 = lo - 4 * hi, hin2 = hin - 4 * hi;
#pragma unroll
        for (int r = 0; r < 16; ++r) { const int kc = crow(r, 0); if (!(kc > lo2 && kc <= hin2)) p0[r] = -INFINITY; if (!(kc + 32 > lo2 && kc + 32 <= hin2)) p1[r] = -INFINITY; }
    }
    float ma = max3f(p0[0], p0[1], p1[0]), mbb = max3f(p0[2], p0[3], p1[1]); ma = max3f(ma, p1[2], p1[3]);
#pragma unroll
    for (int r = 4; r < 16; r += 4) { ma = max3f(ma, p0[r], p0[r + 1]); mbb = max3f(mbb, p0[r + 2], p0[r + 3]); ma = max3f(ma, p1[r], p1[r + 1]); mbb = max3f(mbb, p1[r + 2], p1[r + 3]); }
    float rm = fmaxf(ma, mbb);
    rm = rowon ? rm : -INFINITY;
    rm = swapmax(rm);
    const float mnew = fmaxf(S.m, rm);
    if (__any(mnew > S.m)) {
        const float mb = (mnew == -INFINITY) ? 0.f : mnew;
        const float f = __builtin_amdgcn_exp2f((S.m - mb) * C2);
        S.l *= f;
        if (hi == 0) wsf[r32] = f;
        asm volatile("s_waitcnt lgkmcnt(0)" ::: "memory");
#pragma unroll
        for (int r = 0; r < 16; ++r) { const float fr_ = wsf[crow(r, hi)]; S.o0[r] *= fr_; S.o1[r] *= fr_; }
        asm volatile("s_waitcnt lgkmcnt(0)" ::: "memory");
        S.m = mnew;
    }
    const float mb2 = rowon ? ((S.m == -INFINITY) ? 0.f : S.m * C2) : INFINITY;
    float s0 = 0.f, s1 = 0.f, s2 = 0.f, s3 = 0.f;
#pragma unroll
    for (int r = 0; r < 16; r += 2) { p0[r] = __builtin_amdgcn_exp2f(p0[r] * C2 - mb2); p1[r] = __builtin_amdgcn_exp2f(p1[r] * C2 - mb2); p0[r + 1] = __builtin_amdgcn_exp2f(p0[r + 1] * C2 - mb2); p1[r + 1] = __builtin_amdgcn_exp2f(p1[r + 1] * C2 - mb2);
        s0 += p0[r]; s1 += p1[r]; s2 += p0[r + 1]; s3 += p1[r + 1]; }
    S.l += (s0 + s1) + (s2 + s3);
    pv_frags(S.o0, S.o1, VF, p0, p1);
}

constexpr float ATT_THR = 8.0f;
__device__ __forceinline__ void qkt_c(f32x16& p0, f32x16& p1, lcp Kt, const bf16x8 (&qr)[4], float c0, int r32, int hi) {
    lcp kb = Kt + hi * 1024 + r32 * 16;
#pragma unroll
    for (int r = 0; r < 16; ++r) { p0[r] = c0; p1[r] = c0; }
#pragma unroll
    for (int ks = 0; ks < 4; ++ks) {
        const bf16x8 b0 = *(LAS const bf16x8*)(kb + ks * 2048), b1 = *(LAS const bf16x8*)(kb + ks * 2048 + 512);
        p0 = __builtin_amdgcn_mfma_f32_32x32x16_bf16(b0, qr[ks], p0, 0, 0, 0);
        p1 = __builtin_amdgcn_mfma_f32_32x32x16_bf16(b1, qr[ks], p1, 0, 0, 0);
    }
}
__device__ __forceinline__ void tile_step2(St& S, lcp Kt, lcp Vt, const bf16x8 (&qr)[4], bool rowon, bool EM, int lo, int hin, LAS float* wsf, int lane) {
    const int r32 = lane & 31, hi = lane >> 5;
    f32x16 p0, p1; qkt_c(p0, p1, Kt, qr, rowon ? -S.m : -INFINITY, r32, hi);
    VFr VF; v_read(VF, Vt, lane);
    __builtin_amdgcn_sched_barrier(0);
    if (EM) {
        const int lo2 = lo - 4 * hi, hin2 = hin - 4 * hi;
#pragma unroll
        for (int r = 0; r < 16; ++r) { const int kc = crow(r, 0); if (!(kc > lo2 && kc <= hin2)) p0[r] = -INFINITY; if (!(kc + 32 > lo2 && kc + 32 <= hin2)) p1[r] = -INFINITY; }
    }
    float ma = max3f(p0[0], p0[1], p1[0]), mbb = max3f(p0[2], p0[3], p1[1]); ma = max3f(ma, p1[2], p1[3]);
#pragma unroll
    for (int r = 4; r < 16; r += 4) { ma = max3f(ma, p0[r], p0[r + 1]); mbb = max3f(mbb, p0[r + 2], p0[r + 3]); ma = max3f(ma, p1[r], p1[r + 1]); mbb = max3f(mbb, p1[r + 2], p1[r + 3]); }
    const float rm = swapmax(fmaxf(ma, mbb));
    if (__any(rm > ATT_THR)) {
        const float d = fmaxf(rm, 0.f);
        const float f = __builtin_amdgcn_exp2f(-d);
        S.m += d; S.l *= f;
        if (hi == 0) wsf[r32] = f;
        asm volatile("s_waitcnt lgkmcnt(0)" ::: "memory");
#pragma unroll
        for (int r = 0; r < 16; ++r) { const float fr_ = wsf[crow(r, hi)]; S.o0[r] *= fr_; S.o1[r] *= fr_; p0[r] -= d; p1[r] -= d; }
        asm volatile("s_waitcnt lgkmcnt(0)" ::: "memory");
    }
    float s0 = 0.f, s1 = 0.f, s2 = 0.f, s3 = 0.f;
#pragma unroll
    for (int r = 0; r < 16; r += 2) { p0[r] = __builtin_amdgcn_exp2f(p0[r]); p1[r] = __builtin_amdgcn_exp2f(p1[r]); p0[r + 1] = __builtin_amdgcn_exp2f(p0[r + 1]); p1[r + 1] = __builtin_amdgcn_exp2f(p1[r + 1]);
        s0 += p0[r]; s1 += p1[r]; s2 += p0[r + 1]; s3 += p1[r + 1]; }
    S.l += (s0 + s1) + (s2 + s3);
    pv_frags(S.o0, S.o1, VF, p0, p1);
}
__device__ __forceinline__ void st_reset2(St& S) { S.o0 = f32x16{}; S.o1 = f32x16{}; S.m = 0.f; S.l = 0.f; }
__device__ __forceinline__ void merge(f32x16& f0, f32x16& f1, const St& S, float gate, LAS float* wsf, int lane) {
    const int r32 = lane & 31, hi = lane >> 5;
    const float lt = swapsum(S.l);
    const float coef = gate / fmaxf(lt, 1e-30f);
    asm volatile("s_waitcnt lgkmcnt(0)" ::: "memory");
    if (hi == 0) wsf[r32] = coef;
    asm volatile("s_waitcnt lgkmcnt(0)" ::: "memory");
#pragma unroll
    for (int r = 0; r < 16; ++r) { const float c = wsf[crow(r, hi)]; f0[r] += c * S.o0[r]; f1[r] += c * S.o1[r]; }
    asm volatile("s_waitcnt lgkmcnt(0)" ::: "memory");
}
}

constexpr int ATT_KBUF = 0, ATT_VBUF = 16384, ATT_WSCR = 32768, ATT_WSTRIDE = 6144;
template <int VAR> __device__ __forceinline__ void phase_attn_prompt(const Frame& F, const Args& a, bf16* Oout) {
    using namespace fa;
    const int lane = F.lane, wave = F.wave, tid = F.tid, r32 = lane & 31, hi = lane >> 5;
    LAS char* lds = (LAS char*)F.lds;
    LAS char* wscr = lds + ATT_WSCR + wave * ATT_WSTRIDE;
    LAS float* impL = (LAS float*)wscr; LAS float* scoreL = (LAS float*)(wscr + 4096); LAS float* wsf = (LAS float*)(wscr + 5120); LAS unsigned* maskL = (LAS unsigned*)(wscr + 5376);
    const bf16* QNB = (const bf16*)(a.ws + WS_QNB); const bf16* QRB = (const bf16*)(a.ws + WS_QRB); const float* GA = (const float*)(a.ws + WS_GATES);
    bf16* O = Oout;
    for (int ui = 0; ui < 4; ++ui) {
        int bg, qt;
        if (F.G == 256) { const int s = F.vcu & 7; bg = F.vcu >> 3; qt = (ui == 0) ? s : (ui == 1) ? 15 - s : (ui == 2) ? 16 + s : 31 - s; }
        else { const int u = F.vcu + ui * F.G; if (ui * F.G >= 1024 || u >= 1024) break; bg = u >> 5; qt = u & 31; }
        const int b = bg >> 2, g = bg & 3;
        const int w0 = (qt >= 8) ? qt - 8 : 0, nwin = qt - w0 + 1, nst = 2 + (qt + 1) + nwin;
        const bf16* Kc = (const bf16*)(a.ws + WS_KCB) + (size_t)bg * 128 * 64; const bf16* Vc = (const bf16*)(a.ws + WS_VCB) + (size_t)bg * 128 * 64;
        const bf16* Ks = (const bf16*)(a.ws + WS_KSB) + (size_t)bg * SEQ * 64; const bf16* Vs = (const bf16*)(a.ws + WS_VSB) + (size_t)bg * SEQ * 64;
        const bf16* Kw = (const bf16*)(a.ws + WS_KWB) + (size_t)bg * SEQ * 64; const bf16* Vw = (const bf16*)(a.ws + WS_VWB) + (size_t)bg * SEQ * 64;
        int lo_ = lane; asm volatile("" : "+v"(lo_));
        const int kkey = wave * 8 + (lo_ & 7), kd8 = lo_ >> 3, vkey = wave * 8 + (lo_ >> 3), vd8 = lo_ & 7;
        const int kgo = kkey * 64 + kd8 * 8, vgo = vkey * 64 + vd8 * 8;
        const int klo = kd8 * 1024 + kkey * 16, vlo = (vd8 >> 2) * 4096 + (vkey >> 3) * 512 + (vkey & 7) * 64 + (vd8 & 3) * 16;
        const int tl = 8 * wave + (r32 >> 2), t = 64 * qt + tl, head = 4 * g + (r32 & 3);
        const size_t trow = (size_t)b * SEQ + t;
        const float g0 = GA[trow * 48 + head * 3], g1 = GA[trow * 48 + head * 3 + 1], g2 = GA[trow * 48 + head * 3 + 2];
        bf16x8 qr[4];
#pragma unroll
        for (int ks = 0; ks < 4; ++ks) qr[ks] = *(const bf16x8*)(QNB + trow * DM + head * 64 + ks * 16 + hi * 8);
        v4u kr0, vr0, kr1, vr1, kr2, vr2;
#define ATT_SRC(st, kp, vp) do { if ((st) < 2) { kp = Kc + (st) * 4096; vp = Vc + (st) * 4096; } else if ((st) < 3 + qt) { kp = Ks + ((st) - 2) * 4096; vp = Vs + ((st) - 2) * 4096; } \
                                 else { kp = Kw + (w0 + (st) - 3 - qt) * 4096; vp = Vw + (w0 + (st) - 3 - qt) * 4096; } } while (0)
#define ATT_LOAD(st, KR, VR) do { const bf16* kp_; const bf16* vp_; ATT_SRC(st, kp_, vp_); KR = *(const v4u*)(kp_ + kgo); VR = *(const v4u*)(vp_ + vgo); } while (0)
#define ATT_WRITE(buf, KR, VR) do { *(LAS v4u*)(lds + ATT_KBUF + (buf) * 8192 + klo) = KR; *(LAS v4u*)(lds + ATT_VBUF + (buf) * 8192 + vlo) = VR; } while (0)
        ATT_LOAD(0, kr0, vr0); ATT_LOAD(1, kr1, vr1); ATT_LOAD(2, kr2, vr2);
        __builtin_amdgcn_sched_barrier(0);
        __syncthreads();
        ATT_WRITE(0, kr0, vr0); ATT_WRITE(1, kr1, vr1);
        __syncthreads();
        if (3 < nst) ATT_LOAD(3, kr0, vr0);
        if (4 < nst) ATT_LOAD(4, kr1, vr1);
        St S; st_reset(S);
        f32x16 fin0, fin1;
        unsigned selmask = 0xffffffffu;
        {
            const int nv2 = ((t >= 31) ? (t - 31) / 16 + 1 : 0) - 4 * hi;
            const int ntile = (qt <= 15) ? 1 : 2;
            float cm = -INFINITY, cl = 0.f;
#pragma unroll 1
            for (int T = 0; T < ntile; ++T) {
                f32x16 p0, p1; qkt(p0, p1, (lcp)(lds + ATT_KBUF + T * 8192), qr, r32, hi);
                float rm = -INFINITY;
#pragma unroll
                for (int r = 0; r < 16; ++r) { const int kc = crow(r, 0) + 64 * T; if (!(kc < nv2)) p0[r] = -INFINITY; if (!(kc + 32 < nv2)) p1[r] = -INFINITY; rm = fmaxf(rm, fmaxf(p0[r], p1[r])); }
                rm = swapmax(rm);
                const float mnew = fmaxf(cm, rm), mb = (mnew == -INFINITY) ? 0.f : mnew;
                float sum = 0.f;
#pragma unroll
                for (int r = 0; r < 16; ++r) sum += __builtin_amdgcn_exp2f((p0[r] - mb) * C2) + __builtin_amdgcn_exp2f((p1[r] - mb) * C2);
                cl = cl * __builtin_amdgcn_exp2f((cm - mb) * C2) + sum; cm = mnew;
            }
            const float inv = 1.0f / fmaxf(swapsum(cl), 1e-30f), mb2 = (cm == -INFINITY) ? 0.f : cm * C2;
#pragma unroll 1
            for (int T = 0; T < ntile; ++T) {
                f32x16 p0, p1; qkt(p0, p1, (lcp)(lds + ATT_KBUF + T * 8192), qr, r32, hi);
#pragma unroll
                for (int r = 0; r < 16; ++r) { const int kc = crow(r, 0) + 64 * T;
                    p0[r] = (kc < nv2) ? __builtin_amdgcn_exp2f(p0[r] * C2 - mb2) * inv : 0.f; p1[r] = (kc + 32 < nv2) ? __builtin_amdgcn_exp2f(p1[r] * C2 - mb2) * inv : 0.f; }
                if (qt > 15) {
#pragma unroll
                for (int r = 0; r < 16; ++r) {
                    float v0 = p0[r], v1 = p1[r];
                    v0 += __shfl_xor(v0, 1); v0 += __shfl_xor(v0, 2); v1 += __shfl_xor(v1, 1); v1 += __shfl_xor(v1, 2);
                    if ((r32 & 3) == 0) { LAS float* ip = impL + (r32 >> 2) * 128 + 64 * T + crow(r, hi); ip[0] = v0; ip[32] = v1; }
                } }
                pv_tile(S.o0, S.o1, (lcp)(lds + ATT_VBUF + T * 8192), p0, p1, lane);
            }
            asm volatile("s_waitcnt lgkmcnt(0)" ::: "memory");
            if (qt <= 15) selmask = 0xffffffffu >> (31 - qt);
            else { const int tk = lane >> 3, j4 = lane & 7; float sj[4];
#pragma unroll
              for (int jj = 0; jj < 4; ++jj) { const int j = 4 * j4 + jj; float imp = 0.f;
#pragma unroll
                  for (int n = -1; n <= 3; ++n) { const int nn = 4 * j + n; if (nn >= 0) imp += impL[tk * 128 + nn]; }
                  const bool forced = (j == 0) || (j == qt) || (j == qt - 1), valid = j <= qt;
                  sj[jj] = forced ? INFINITY : (valid ? imp : -INFINITY); scoreL[tk * 32 + j] = sj[jj]; }
              asm volatile("s_waitcnt lgkmcnt(0)" ::: "memory");
              int rk0 = 0, rk1 = 0, rk2 = 0, rk3 = 0;
              for (int i = 0; i < 32; ++i) { const float si = scoreL[tk * 32 + i]; const int j = 4 * j4;
                  rk0 += (si > sj[0] || (si == sj[0] && i < j)) ? 1 : 0; rk1 += (si > sj[1] || (si == sj[1] && i < j + 1)) ? 1 : 0;
                  rk2 += (si > sj[2] || (si == sj[2] && i < j + 2)) ? 1 : 0; rk3 += (si > sj[3] || (si == sj[3] && i < j + 3)) ? 1 : 0; }
              unsigned bits = 0u;
              if (rk0 < 16 && sj[0] > -INFINITY) bits |= 1u << (4 * j4);
              if (rk1 < 16 && sj[1] > -INFINITY) bits |= 2u << (4 * j4);
              if (rk2 < 16 && sj[2] > -INFINITY) bits |= 4u << (4 * j4);
              if (rk3 < 16 && sj[3] > -INFINITY) bits |= 8u << (4 * j4);
              bits |= __shfl_xor(bits, 1); bits |= __shfl_xor(bits, 2); bits |= __shfl_xor(bits, 4);
              if (j4 == 0) maskL[tk] = bits;
              asm volatile("s_waitcnt lgkmcnt(0)" ::: "memory");
              selmask = maskL[r32 >> 2];
              asm volatile("s_waitcnt lgkmcnt(0)" ::: "memory"); }
            fin0 = f32x16{}; fin1 = f32x16{};
            S.l = 0.5f;
            merge(fin0, fin1, S, g0, wsf, lane); st_reset2(S);
#pragma unroll
            for (int ks = 0; ks < 4; ++ks) { const bf16x8 qv = *(const bf16x8*)(QRB + trow * DM + head * 64 + ks * 16 + hi * 8);
                v4u w;
#pragma unroll
                for (int e = 0; e < 4; ++e) { const unsigned lo16 = (unsigned short)qv[2 * e], hi16 = (unsigned short)qv[2 * e + 1];
                    w[e] = cvtpk(__builtin_bit_cast(float, lo16 << 16) * C2, __builtin_bit_cast(float, hi16 << 16) * C2); }
                qr[ks] = __builtin_bit_cast(bf16x8, w); }
            __syncthreads();
            ATT_WRITE(0, kr2, vr2);
            __syncthreads();
        }
#define ATT_STEP(ST, KL, VL, KW, VW) do { const int st_ = (ST); \
            if (VAR != 1 && st_ + 3 < nst) ATT_LOAD(st_ + 3, KL, VL); \
            lcp Kt = (lcp)(lds + ATT_KBUF + (st_ & 1) * 8192); lcp Vt = (lcp)(lds + ATT_VBUF + (st_ & 1) * 8192); \
            const bool slc = st_ < 3 + qt; \
            const int kt = slc ? st_ - 2 : w0 + st_ - 3 - qt; \
            const bool on = slc ? ((selmask >> kt) & 1u) : true; \
            const bool em = (kt == qt) || (!slc && kt == qt - 8); \
            const int lo = (!slc && kt == qt - 8) ? tl : -1, hin = (kt == qt) ? tl : 63; \
            if (VAR != 1) { if (st_ + 1 < nst) ATT_WRITE((st_ + 1) & 1, KW, VW); }     \
            if (VAR != 2) tile_step2(S, Kt, Vt, qr, on, em, lo, hin, wsf, lane); \
            if (kt == qt) { merge(fin0, fin1, S, slc ? g1 : g2, wsf, lane); st_reset2(S); } \
            if (VAR != 1) { __syncthreads(); } } while (0)
#pragma unroll 1
        for (int st = 2; st < nst; st += 3) {
            ATT_STEP(st, kr2, vr2, kr0, vr0);
            if (st + 1 < nst) ATT_STEP(st + 1, kr0, vr0, kr1, vr1);
            if (st + 2 < nst) ATT_STEP(st + 2, kr1, vr1, kr2, vr2);
        }
#undef ATT_STEP
#pragma unroll
        for (int r = 0; r < 16; ++r) { const int q = crow(r, hi); bf16* op = O + ((size_t)b * SEQ + 64 * qt + 8 * wave + (q >> 2)) * DM + (4 * g + (q & 3)) * 64 + r32;
            op[0] = (bf16)f2bf(fin0[r]); op[32] = (bf16)f2bf(fin1[r]); }
#undef ATT_SRC
#undef ATT_LOAD
#undef ATT_WRITE
    }
}


namespace fa {
__device__ __forceinline__ bf16x8 pack8(const f32x4& a, const f32x4& b) {
    v4u w; w.x = cvtpk(a.x, a.y); w.y = cvtpk(a.z, a.w); w.z = cvtpk(b.x, b.y); w.w = cvtpk(b.z, b.w); return __builtin_bit_cast(bf16x8, w);
}
__device__ __forceinline__ int offv32(int key, int d8) { return (d8 >> 2) * 2048 + (key >> 3) * 512 + (key & 7) * 64 + (d8 & 3) * 16; }
__device__ __forceinline__ void load_half_f32(const float* base, int nvalid, bool needv, bf16x8 (&kf)[4], LAS char* Vimg, LAS char* Kimg, int lane) {
    typedef unsigned u32x2v __attribute__((ext_vector_type(2)));
    const int r32 = lane & 31, hi = lane >> 5, kq = lane >> 4, pc = lane & 15;
    f32x4 kx[8], vx[8];
#pragma unroll
    for (int i = 0; i < 8; ++i) kx[i] = __builtin_nontemporal_load((const f32x4*)(base + (size_t)min(4 * i + kq, nvalid - 1) * 512 + pc * 4));
    if (needv) {
#pragma unroll
        for (int i = 0; i < 8; ++i) vx[i] = __builtin_nontemporal_load((const f32x4*)(base + 256 + (size_t)min(4 * i + kq, nvalid - 1) * 512 + pc * 4));
    }
    __builtin_amdgcn_sched_barrier(0);
#pragma unroll
    for (int i = 0; i < 8; ++i) { u32x2v w; w.x = cvtpk(kx[i].x, kx[i].y); w.y = cvtpk(kx[i].z, kx[i].w); *(LAS u32x2v*)(Kimg + (4 * i + kq) * 144 + pc * 8) = w; }
    if (needv) {
#pragma unroll
        for (int i = 0; i < 8; ++i) { u32x2v w; w.x = cvtpk(vx[i].x, vx[i].y); w.y = cvtpk(vx[i].z, vx[i].w); *(LAS u32x2v*)(Vimg + offv32(4 * i + kq, pc >> 1) + (pc & 1) * 8) = w; }
    }
    asm volatile("s_waitcnt lgkmcnt(0)" ::: "memory");
#pragma unroll
    for (int ks = 0; ks < 4; ++ks) kf[ks] = *(const LAS bf16x8*)(Kimg + r32 * 144 + ks * 32 + hi * 16);
    asm volatile("s_waitcnt lgkmcnt(0)" ::: "memory");
}
__device__ __forceinline__ void load_half_bf16(const bf16* Kb, const bf16* Vb, bool needv, bf16x8 (&kf)[4], LAS char* Vimg, int lane) {
    const int r32 = lane & 31, hi = lane >> 5;
#pragma unroll
    for (int ks = 0; ks < 4; ++ks) kf[ks] = *(const bf16x8*)(Kb + r32 * 64 + 16 * ks + 8 * hi);
    if (needv) {
        bf16x8 vx[4];
#pragma unroll
        for (int i = 0; i < 4; ++i) vx[i] = *(const bf16x8*)(Vb + ((lane >> 3) + 8 * i) * 64 + (lane & 7) * 8);
#pragma unroll
        for (int i = 0; i < 4; ++i) *(LAS bf16x8*)(Vimg + offv32((lane >> 3) + 8 * i, lane & 7)) = vx[i];
    }
    asm volatile("s_waitcnt lgkmcnt(0)" ::: "memory");
}
__device__ __forceinline__ void qk_half(f32x16& p, const bf16x8 (&kf)[4], const bf16x8 (&qr)[4]) {
    p = f32x16{};
#pragma unroll
    for (int ks = 0; ks < 4; ++ks) p = __builtin_amdgcn_mfma_f32_32x32x16_bf16(kf[ks], qr[ks], p, 0, 0, 0);
}
__device__ __forceinline__ void pv_half(f32x16& o0, f32x16& o1, lcp Vt, const f32x16& p, int lane) {
    const int hi = lane >> 5;
    bf16x8 pa[2];
#pragma unroll
    for (int k = 0; k < 2; ++k) { v4u w; w.x = cvtpk(p[8 * k], p[8 * k + 1]); w.y = cvtpk(p[8 * k + 2], p[8 * k + 3]); w.z = cvtpk(p[8 * k + 4], p[8 * k + 5]); w.w = cvtpk(p[8 * k + 6], p[8 * k + 7]); pa[k] = __builtin_bit_cast(bf16x8, w); }
    lcp vb = Vt + ((lane >> 4) & 1) * 32 + (lane & 3) * 8 + (4 * hi + ((lane & 15) >> 2)) * 64;
#pragma unroll
    for (int ks = 0; ks < 2; ++ks) {
        const s16x4 a0 = vtr(vb + ks * 1024), a1 = vtr(vb + ks * 1024 + 512), b0 = vtr(vb + 2048 + ks * 1024), b1 = vtr(vb + 2048 + ks * 1024 + 512);
        const bf16x8 v0 = (bf16x8){a0[0], a0[1], a0[2], a0[3], a1[0], a1[1], a1[2], a1[3]}, v1 = (bf16x8){b0[0], b0[1], b0[2], b0[3], b1[0], b1[1], b1[2], b1[3]};
        o0 = __builtin_amdgcn_mfma_f32_32x32x16_bf16(pa[ks], v0, o0, 0, 0, 0);
        o1 = __builtin_amdgcn_mfma_f32_32x32x16_bf16(pa[ks], v1, o1, 0, 0, 0);
    }
}
__device__ __forceinline__ void half_step(St& S, const bf16x8 (&kf)[4], lcp Vt, const bf16x8 (&qr)[4], bool rowon, bool EM, int lo, int hin, LAS float* wsf, int lane) {
    const int r32 = lane & 31, hi = lane >> 5;
    f32x16 p; qk_half(p, kf, qr);
    if (EM) { const int lo2 = lo - 4 * hi, hin2 = hin - 4 * hi;
#pragma unroll
        for (int r = 0; r < 16; ++r) { const int kc = crow(r, 0); if (!(kc > lo2 && kc <= hin2)) p[r] = -INFINITY; } }
    float rm = p[0];
#pragma unroll
    for (int r = 1; r < 16; ++r) rm = fmaxf(rm, p[r]);
    rm = rowon ? rm : -INFINITY;
    rm = swapmax(rm);
    const float mnew = fmaxf(S.m, rm);
    if (__any(mnew > S.m)) {
        const float mb = (mnew == -INFINITY) ? 0.f : mnew;
        const float f = __builtin_amdgcn_exp2f((S.m - mb) * C2);
        S.l *= f;
        if (hi == 0) wsf[r32] = f;
        asm volatile("s_waitcnt lgkmcnt(0)" ::: "memory");
#pragma unroll
        for (int r = 0; r < 16; ++r) { const float fr_ = wsf[crow(r, hi)]; S.o0[r] *= fr_; S.o1[r] *= fr_; }
        asm volatile("s_waitcnt lgkmcnt(0)" ::: "memory");
        S.m = mnew;
    }
    const float mb2 = rowon ? ((S.m == -INFINITY) ? 0.f : S.m * C2) : INFINITY;
    float sum = 0.f;
#pragma unroll
    for (int r = 0; r < 16; ++r) { p[r] = __builtin_amdgcn_exp2f(p[r] * C2 - mb2); sum += p[r]; }
    S.l += sum;
    pv_half(S.o0, S.o1, Vt, p, lane);
}
}

constexpr int SA_WREG = 9216, SA_IMP = 73728, SA_PART = 77824, SA_ML = 143360, SA_SEL = 145408;
static_assert(SA_SEL + 64 <= MISC_OFF && 8 * SA_WREG <= SA_IMP && SA_IMP + 3072 <= SA_PART && SA_PART + 16 * 4096 <= SA_ML && SA_ML + 2048 <= SA_SEL, "sample-attention LDS map");
__device__ __forceinline__ void sa_store_partial(const fa::St& S, LAS char* lds, int slot, int lane) {
    const int r32 = lane & 31, hi = lane >> 5;
    LAS float* pp = (LAS float*)(lds + SA_PART + slot * 4096);
#pragma unroll
    for (int r = 0; r < 8; ++r) { const int row = fa::crow(r, hi); pp[row * 64 + r32] = S.o0[r]; pp[row * 64 + 32 + r32] = S.o1[r]; }
    const float lt = fa::swapsum(S.l);
    if (lane < 16) { LAS float* ml = (LAS float*)(lds + SA_ML + slot * 128); ml[2 * lane] = S.m; ml[2 * lane + 1] = lt; }
}
__device__ __forceinline__ void phase_attn_sample(const Frame& F, const Args& a) {
    using namespace fa;
    const int lane = F.lane, wave = F.wave, tid = F.tid, r32 = lane & 31, hi = lane >> 5;
    LAS char* lds = (LAS char*)F.lds;
    LAS char* Vimg = lds + wave * SA_WREG; LAS char* Kimg = Vimg + 4096;
    LAS float* wsf = (LAS float*)(Vimg + 8704);
    LAS float* impL = (LAS float*)(lds + SA_IMP); LAS float* scoreL = (LAS float*)(lds + SA_IMP + 2048);
    LAS unsigned* selL = (LAS unsigned*)(lds + SA_SEL);
    const bf16* QNB = (const bf16*)(a.ws + WS_QNB); const bf16* QRB = (const bf16*)(a.ws + WS_QRB); const float* GA = (const float*)(a.ws + WS_GATES);
    const float* cslc = (const float*)a.in[I_CSLC]; const float* swin = (const float*)a.in[I_SWIN]; const int* pt = (const int*)a.in[I_PT];
    const float* KVS = a.out + O_KVSLC; const float* KVW = (const float*)(a.ws + WS_KVWIN);
    bf16* O = (bf16*)(a.ws + WS_O);
    for (int u = F.vcu; u < 512; u += F.G) {
        const int sidx = u >> 2, g = u & 3;
        const int row16 = r32 & 15, ti = row16 >> 2, head = 4 * g + (row16 & 3);
        const size_t qrow = (size_t)MP + 4 * sidx + ti;
        __syncthreads();
        if (wave == 0) {
            bf16x8 qr[4];
#pragma unroll
            for (int ks = 0; ks < 4; ++ks) qr[ks] = *(const bf16x8*)(QNB + qrow * DM + head * 64 + ks * 16 + hi * 8);
            const bf16* Kc = (const bf16*)(a.ws + WS_KCB) + ((size_t)(8 + sidx) * 4 + g) * 128 * 64; const bf16* Vc = (const bf16*)(a.ws + WS_VCB) + ((size_t)(8 + sidx) * 4 + g) * 128 * 64;
            float cm = -INFINITY, cl = 0.f;
#pragma unroll 1
            for (int h = 0; h < 4; ++h) {
                bf16x8 kf[4]; load_half_bf16(Kc + h * 2048, Vc + h * 2048, false, kf, Vimg, lane);
                f32x16 p; qk_half(p, kf, qr);
                const int nv2 = 127 - 32 * h - 4 * hi; float rm = -INFINITY;
#pragma unroll
                for (int r = 0; r < 16; ++r) { if (!(crow(r, 0) < nv2)) p[r] = -INFINITY; rm = fmaxf(rm, p[r]); }
                rm = swapmax(rm);
                const float mnew = fmaxf(cm, rm); float sum = 0.f;
#pragma unroll
                for (int r = 0; r < 16; ++r) sum += __builtin_amdgcn_exp2f((p[r] - mnew) * C2);
                cl = cl * __builtin_amdgcn_exp2f((cm - mnew) * C2) + sum; cm = mnew;
            }
            const float inv = 1.0f / fmaxf(swapsum(cl), 1e-30f), mb2 = cm * C2;
            St S; st_reset(S);
#pragma unroll 1
            for (int h = 0; h < 4; ++h) {
                bf16x8 kf[4]; load_half_bf16(Kc + h * 2048, Vc + h * 2048, true, kf, Vimg, lane);
                f32x16 p; qk_half(p, kf, qr);
                const int nv2 = 127 - 32 * h - 4 * hi;
#pragma unroll
                for (int r = 0; r < 16; ++r) p[r] = (crow(r, 0) < nv2) ? __builtin_amdgcn_exp2f(p[r] * C2 - mb2) * inv : 0.f;
#pragma unroll
                for (int r = 0; r < 16; ++r) { float v0 = p[r]; v0 += __shfl_xor(v0, 1); v0 += __shfl_xor(v0, 2);
                    if ((r32 & 3) == 0 && r32 < 16) impL[(r32 >> 2) * 128 + 32 * h + crow(r, hi)] = v0; }
                pv_half(S.o0, S.o1, (lcp)Vimg, p, lane);
            }
            S.m = 0.f; S.l = 0.5f;
            sa_store_partial(S, lds, 0, lane);
            asm volatile("s_waitcnt lgkmcnt(0)" ::: "memory");
            { const int tk = lane >> 4, jg = lane & 15; float sj[3];
#pragma unroll
              for (int jj = 0; jj < 3; ++jj) { const int j = 3 * jg + jj; float imp = 0.f;
#pragma unroll
                  for (int n = -1; n <= 3; ++n) { const int nn = 4 * j + n; if (nn >= 0 && nn < 127) imp += impL[tk * 128 + nn]; }
                  const bool forced = (j == 0) || (j == 32) || (j == 31);
                  sj[jj] = forced ? INFINITY : ((j <= 32) ? imp : -INFINITY); scoreL[tk * 64 + j] = sj[jj]; }
              asm volatile("s_waitcnt lgkmcnt(0)" ::: "memory");
              int rk0 = 0, rk1 = 0, rk2 = 0;
              for (int i = 0; i < 33; ++i) { const float si = scoreL[tk * 64 + i]; const int j = 3 * jg;
                  rk0 += (si > sj[0] || (si == sj[0] && i < j)) ? 1 : 0; rk1 += (si > sj[1] || (si == sj[1] && i < j + 1)) ? 1 : 0; rk2 += (si > sj[2] || (si == sj[2] && i < j + 2)) ? 1 : 0; }
              unsigned long long bits = 0ull;
              if (rk0 < 16 && sj[0] > -INFINITY) bits |= 1ull << (3 * jg);
              if (rk1 < 16 && sj[1] > -INFINITY) bits |= 2ull << (3 * jg);
              if (rk2 < 16 && sj[2] > -INFINITY) bits |= 4ull << (3 * jg);
              unsigned blo = (unsigned)bits, bhi = (unsigned)(bits >> 32);
#pragma unroll
              for (int o = 1; o < 16; o <<= 1) { blo |= __shfl_xor(blo, o); bhi |= __shfl_xor(bhi, o); }
              if (jg == 0) { selL[2 * tk] = blo; selL[2 * tk + 1] = bhi; } }
        } else {
            bf16x8 qr[4];
#pragma unroll
            for (int ks = 0; ks < 4; ++ks) qr[ks] = *(const bf16x8*)(QRB + qrow * DM + head * 64 + ks * 16 + hi * 8);
            St S; st_reset(S);
#pragma unroll 1
            for (int it = wave - 1; it < 17; it += 7) {
                bf16x8 kf[4];
                if (it < 16) { load_half_f32(swin + ((size_t)sidx * 512 + 32 * it) * 512 + g * 64, 32, true, kf, Vimg, Kimg, lane);
                    half_step(S, kf, (lcp)Vimg, qr, true, it == 0, ti, 31, wsf, lane); }
                else { load_half_f32(KVW + ((size_t)MP + 4 * sidx) * 512 + g * 64, 4, true, kf, Vimg, Kimg, lane);
                    half_step(S, kf, (lcp)Vimg, qr, true, true, -1, ti, wsf, lane); }
            }
            sa_store_partial(S, lds, wave, lane);
        }
        __syncthreads();
        {
            bf16x8 qr[4];
#pragma unroll
            for (int ks = 0; ks < 4; ++ks) qr[ks] = *(const bf16x8*)(QRB + qrow * DM + head * 64 + ks * 16 + hi * 8);
            const unsigned mlo = selL[2 * ti], mhi = selL[2 * ti + 1];
            const unsigned ulo = selL[0] | selL[2] | selL[4] | selL[6];
            St S; st_reset(S);
            int cnt = 0;
#pragma unroll 1
            for (int j = 0; j < 32; ++j) {
                if (!((ulo >> j) & 1u)) continue;
                const float* bbase = cslc + ((size_t)pt[sidx * 16 + (j >> 1)] * 128 + (j & 1) * 64) * 512 + g * 64;
#pragma unroll 1
                for (int h = 0; h < 2; ++h) {
                    if ((cnt++ & 7) != wave) continue;
                    bf16x8 kf[4]; load_half_f32(bbase + (size_t)h * 32 * 512, 32, true, kf, Vimg, Kimg, lane);
                    half_step(S, kf, (lcp)Vimg, qr, (mlo >> j) & 1u, false, 0, 0, wsf, lane);
                }
            }
            if ((cnt & 7) == wave) {
                bf16x8 kf[4]; load_half_f32(KVS + ((size_t)MP + 4 * sidx) * 512 + g * 64, 4, true, kf, Vimg, Kimg, lane);
                half_step(S, kf, (lcp)Vimg, qr, mhi & 1u, true, -1, ti, wsf, lane);
            }
            sa_store_partial(S, lds, 8 + wave, lane);
        }
        __syncthreads();
        {
            const int row = tid >> 5, d = (tid & 31) * 2;
            const size_t orow = (size_t)MP + 4 * sidx + (row >> 2); const int oh = 4 * g + (row & 3);
            const float g0 = GA[orow * 48 + oh * 3], g1 = GA[orow * 48 + oh * 3 + 1], g2 = GA[orow * 48 + oh * 3 + 2];
            const LAS float* part = (const LAS float*)(lds + SA_PART); const LAS float* ml = (const LAS float*)(lds + SA_ML);
            float r0 = g0 * part[row * 64 + d], r1 = g0 * part[row * 64 + d + 1];
#pragma unroll
            for (int br = 0; br < 2; ++br) {
                const int s0 = br ? 8 : 1, s1 = br ? 16 : 8;
                float Mx = -INFINITY;
                for (int w = s0; w < s1; ++w) Mx = fmaxf(Mx, ml[w * 32 + 2 * row]);
                float L = 0.f, a0 = 0.f, a1 = 0.f;
                for (int w = s0; w < s1; ++w) { const float mw = ml[w * 32 + 2 * row]; const float f = (mw == -INFINITY) ? 0.f : __builtin_amdgcn_exp2f((mw - Mx) * C2);
                    L += f * ml[w * 32 + 2 * row + 1]; a0 += f * part[w * 1024 + row * 64 + d]; a1 += f * part[w * 1024 + row * 64 + d + 1]; }
                const float c = (br ? g1 : g2) / fmaxf(L, 1e-30f);
                r0 += c * a0; r1 += c * a1;
            }
            *(unsigned*)(O + orow * DM + oh * 64 + d) = pk2(r0, r1);
        }
    }
}


__device__ __forceinline__ void phase_compress_fast(const Frame& F, const Args& a, const int u_lo, const int u_hi, const int ubase, const int ustride) {
    using namespace fa;
    const int lane = F.lane, wave = F.wave, tid = F.tid, r32 = lane & 31, hi = lane >> 5;
    LAS float* PL = (LAS float*)F.lds + wave * 4096;
    LAS char* BL = (LAS char*)F.lds;
    LAS char* AL = (LAS char*)F.lds + 65536 + wave * 6656;
    const int* pt = (const int*)a.in[I_PT]; const float* cc = (const float*)a.in[I_CCMP];
    const float* knc = (const float*)a.in[I_KNC];
    const int g = wave >> 1, kv = wave & 1;
    for (int u = u_lo + ubase; u < u_hi; u += ustride) {
        const int seq = u / 5, jt = u % 5;
        const float* abase = (seq < 8) ? a.out + O_KVCMP + (size_t)seq * SEQ * 512 : cc;
        __syncthreads();
        LAS unsigned* RA = (LAS unsigned*)(AL + 4608) + lane;
#pragma unroll
        for (int i = 0; i < 8; ++i) { const int jj = min(31 * jt + 4 * i + (lane >> 4), 127);
            const unsigned rowi = (seq < 8) ? (unsigned)(16 * jj) : (unsigned)pt[(seq - 8) * 16 + (jj >> 3)] * 128u + (unsigned)((16 * jj) & 127);
            RA[64 * i] = rowi * 512u + (unsigned)(kv * 256 + g * 64 + (lane & 15) * 4); }
        asm volatile("s_waitcnt lgkmcnt(0)" ::: "memory");
        const int awo = (lane >> 4) * 144 + (lane & 15) * 8, aro = r32 * 144 + hi * 64;
        f32x16 acc[4];
#pragma unroll
        for (int c = 0; c < 4; ++c) acc[c] = f32x16{};
        f32x4 xa[8], xb[8], xc[8]; v4u br0[4], br1[4];
        const bf16* wtb = (const bf16*)(a.ws + WS_CWT) + tid * 8;
#define CMP_LDA(X, LL) do { _Pragma("unroll") for (int i = 0; i < 8; ++i) X[i] = __builtin_nontemporal_load((const f32x4*)(abase + (RA[64 * i] + (unsigned)((LL) * 512)))); } while (0)
#define CMP_LDB(BR, LL) do { _Pragma("unroll") for (int i = 0; i < 4; ++i) BR[i] = *(const v4u*)(wtb + ((LL) * 8192 + (i & 1) * 4096 + (i >> 1) * 131072)); } while (0)
#define CMP_STB(BR, BUF) do { _Pragma("unroll") for (int i = 0; i < 4; ++i) *(LAS v4u*)(BL + (BUF) * 32768 + (tid + 512 * i) * 16) = BR[i]; } while (0)
        CMP_LDB(br0, 0); CMP_LDA(xa, 0); CMP_LDA(xb, 1); CMP_LDB(br1, 1);
        CMP_STB(br0, 0);
        __syncthreads();
#define CMP_STEP(LL, XC, XN, BW, BLD) do { const int l_ = (LL); \
            if (l_ + 2 < 16) { CMP_LDA(XN, l_ + 2); CMP_LDB(BLD, l_ + 2); } \
            __builtin_amdgcn_sched_barrier(0); \
            _Pragma("unroll") for (int i = 0; i < 8; ++i) { typedef unsigned u32x2v __attribute__((ext_vector_type(2))); u32x2v w; w.x = cvtpk(XC[i].x, XC[i].y); w.y = cvtpk(XC[i].z, XC[i].w); \
                *(LAS u32x2v*)(AL + i * 576 + awo) = w; } \
            asm volatile("s_waitcnt lgkmcnt(0)" ::: "memory"); \
            { lcp bb = (lcp)(BL + (l_ & 1) * 32768 + kv * 16384 + lane * 16); \
              _Pragma("unroll") for (int sx = 0; sx < 4; ++sx) { const bf16x8 af = *(const LAS bf16x8*)(AL + aro + sx * 16); \
                _Pragma("unroll") for (int c = 0; c < 4; ++c) { const bf16x8 bf = *(LAS const bf16x8*)(bb + (sx * 4 + c) * 1024); acc[c] = __builtin_amdgcn_mfma_f32_32x32x16_bf16(af, bf, acc[c], 0, 0, 0); } \
                if (sx & 1) __builtin_amdgcn_sched_barrier(0); } } \
            __builtin_amdgcn_sched_barrier(0); \
            if (l_ + 1 < 16) CMP_STB(BW, (l_ + 1) & 1); \
            __syncthreads(); } while (0)
#pragma unroll 1
        for (int l0 = 0; l0 < 16; l0 += 6) {
            CMP_STEP(l0, xa, xc, br1, br0);
            CMP_STEP(l0 + 1, xb, xa, br0, br1);
            CMP_STEP(l0 + 2, xc, xb, br1, br0);
            CMP_STEP(l0 + 3, xa, xc, br0, br1);
            if (l0 + 4 < 16) { CMP_STEP(l0 + 4, xb, xa, br1, br0); CMP_STEP(l0 + 5, xc, xb, br0, br1); }
        }
#undef CMP_LDA
#undef CMP_LDB
#undef CMP_STB
#undef CMP_STEP
        asm volatile("s_waitcnt lgkmcnt(0)" ::: "memory");
#pragma unroll
        for (int c = 0; c < 4; ++c)
#pragma unroll
            for (int r = 0; r < 16; ++r) PL[crow(r, hi) * 128 + 32 * c + r32] = acc[c][r];
        asm volatile("s_waitcnt lgkmcnt(0)" ::: "memory");
        {   const int nl = lane >> 1, e0 = 32 * (lane & 1), n = 31 * jt + nl;
            const bool live = (nl < 31) && (n < 127);
            if (live || n == 127) {
                const float* bias = (const float*)(a.ws + WS_CBIAS) + kv * 64 + e0;
                float v[32]; float ss = 0.f;
#pragma unroll
                for (int i = 0; i < 32; ++i) { v[i] = live ? PL[nl * 128 + e0 + i] + PL[(nl + 1) * 128 + 64 + e0 + i] + bias[i] : 0.f; ss += v[i] * v[i]; }
                if (!kv) { ss += __shfl_xor(ss, 1); const float rs = 1.0f / sqrtf(ss * (1.f / 64) + EPS);
#pragma unroll
                    for (int i = 0; i < 32; ++i) v[i] = v[i] * rs * knc[e0 + i]; }
                bf16* bd = (bf16*)(a.ws + (kv ? WS_VCB : WS_KCB)) + (((size_t)seq * 4 + g) * 128 + n) * 64 + e0;
#pragma unroll
                for (int i = 0; i < 4; ++i) { v4u w; w.x = pk2(v[8 * i], v[8 * i + 1]); w.y = pk2(v[8 * i + 2], v[8 * i + 3]); w.z = pk2(v[8 * i + 4], v[8 * i + 5]); w.w = pk2(v[8 * i + 6], v[8 * i + 7]); *(v4u*)(bd + 8 * i) = w; }
            }
        }
        asm volatile("s_waitcnt lgkmcnt(0)" ::: "memory");
    }
}

__device__ __forceinline__ void ln_row_stats(const float* LNP, size_t row, int q, float& mean, float& rstd) {
    const f32x4* p = (const f32x4*)(LNP + (row * 32 + 8 * q) * 2);
    float sm = 0.f, sq = 0.f;
#pragma unroll
    for (int i = 0; i < 4; ++i) { const f32x4 v = p[i]; sm += v.x + v.z; sq += v.y + v.w; }
    sm += __shfl_xor(sm, 1); sm += __shfl_xor(sm, 2); sq += __shfl_xor(sq, 1); sq += __shfl_xor(sq, 2);
    mean = sm * (1.f / DA); const float var = fmaxf(sq * (1.f / DA) - mean * mean, 0.f); rstd = 1.0f / sqrtf(var + EPS);
}
__device__ __forceinline__ void phase_spatial_fast(const Frame& F, const Args& a, const int l) {
    using namespace fa;
    const int lane = F.lane, wave = F.wave, tid = F.tid, r32 = lane & 31, hi = lane >> 5;
    LAS char* lds = (LAS char*)F.lds;
    LAS float* stL = (LAS float*)(lds + 65536);
    LAS char* WFL = lds + 69632;
    int g_prev = -1;
    const bf16* UV = (const bf16*)(a.ws + WS_UV); const float* LNP = (const float*)(a.ws + WS_LNP); bf16* GT = (bf16*)(a.ws + WS_GATED);
    const float* lng = (const float*)a.in[I_ALNG] + l * DA; const float* lnb = (const float*)a.in[I_ALNB] + l * DA;
    const float* wsp = (const float*)a.in[I_AWS] + (size_t)l * 8 * 128 * 128; const float* bsp = (const float*)a.in[I_ABS] + l * 8 * 128;
    v4u vq[8]; f32x4 lp[4];
    if (F.vcu < 1024) { const int u = F.vcu; const size_t row0 = (size_t)(u >> 3) * 128; const int chn = (u & 7) * 256 + (tid & 31) * 8;
#pragma unroll
        for (int i = 0; i < 8; ++i) vq[i] = *(const v4u*)(UV + (row0 + (tid >> 5) + 16 * i) * 4096 + 2048 + chn);
        const f32x4* p = (const f32x4*)(LNP + ((row0 + (tid >> 2)) * 32 + 8 * (tid & 3)) * 2);
#pragma unroll
        for (int i = 0; i < 4; ++i) lp[i] = p[i]; }
    float gg[8], bb[8], btv[4]; int g_par = -1;
    for (int u = F.vcu; u < 1024; u += F.G) {
        const int c = u >> 3, g = u & 7;
        const size_t row0 = (size_t)c * 128; const int ch0 = g * 256;
        if (g != g_par) { const int chn = ch0 + (tid & 31) * 8;
#pragma unroll
            for (int i = 0; i < 8; ++i) { gg[i] = lng[chn + i]; bb[i] = lnb[chn + i]; }
#pragma unroll
            for (int tt = 0; tt < 4; ++tt) btv[tt] = bsp[g * 128 + 32 * tt + r32];
            g_par = g; }
        v4u uq[8];
        {   const int chu = ch0 + 32 * wave + 8 * (lane & 3);
#pragma unroll
            for (int i = 0; i < 8; ++i) uq[i] = *(const v4u*)(UV + (row0 + 16 * i + (lane >> 2)) * 4096 + chu); }
        __builtin_amdgcn_sched_barrier(0);
        float mean_t, rstd_t;
        {   float sm = 0.f, sq = 0.f;
#pragma unroll
            for (int i = 0; i < 4; ++i) { sm += lp[i].x + lp[i].z; sq += lp[i].y + lp[i].w; }
            sm += __shfl_xor(sm, 1); sm += __shfl_xor(sm, 2); sq += __shfl_xor(sq, 1); sq += __shfl_xor(sq, 2);
            mean_t = sm * (1.f / DA); const float var = fmaxf(sq * (1.f / DA) - mean_t * mean_t, 0.f); rstd_t = 1.0f / sqrtf(var + EPS); }
        __syncthreads();
        if ((tid & 3) == 0) { stL[2 * (tid >> 2)] = mean_t; stL[2 * (tid >> 2) + 1] = rstd_t; }
        __syncthreads();
        {
            const int ck = tid & 31;
#pragma unroll
            for (int i = 0; i < 8; ++i) {
                const int sr = (tid >> 5) + 16 * i;
                const float mean = stL[2 * sr], rstd = stL[2 * sr + 1];
                const v4u vv = vq[i];
                v4u o;
#pragma unroll
                for (int e = 0; e < 4; ++e) { const unsigned ww = vv[e];
                    o[e] = pk2((__builtin_bit_cast(float, ww << 16) - mean) * rstd * gg[2 * e] + bb[2 * e], (__builtin_bit_cast(float, ww & 0xffff0000u) - mean) * rstd * gg[2 * e + 1] + bb[2 * e + 1]); }
                *(LAS v4u*)(lds + (ck >> 2) * 8192 + (sr >> 3) * 512 + (sr & 7) * 64 + (ck & 3) * 16) = o;
            }
        }
        if (g != g_prev) {
            const float* wg = wsp + (size_t)g * 128 * 128;
            for (int cell = tid; cell < 20 * 64; cell += NTHR) {
                const int f = cell >> 6, ln = cell & 63, tt = (f >= 12) ? 3 : (f >= 6) ? 2 : (f >= 2) ? 1 : 0, ks = f - tt * (tt + 1), rr = ln & 31, hh = ln >> 5;
                const int t = 32 * tt + rr, sb = 16 * ks + 4 * hh;
                const float* wp = wg + (size_t)t * 128 + sb;
                f32x4 x0 = *(const f32x4*)wp, x1 = *(const f32x4*)(wp + 8);
                x0.x = (sb + 0 <= t) ? x0.x : 0.f; x0.y = (sb + 1 <= t) ? x0.y : 0.f; x0.z = (sb + 2 <= t) ? x0.z : 0.f; x0.w = (sb + 3 <= t) ? x0.w : 0.f;
                x1.x = (sb + 8 <= t) ? x1.x : 0.f; x1.y = (sb + 9 <= t) ? x1.y : 0.f; x1.z = (sb + 10 <= t) ? x1.z : 0.f; x1.w = (sb + 11 <= t) ? x1.w : 0.f;
                *(LAS bf16x8*)(WFL + cell * 16) = pack8(x0, x1);
            }
            g_prev = g;
        }
        __builtin_amdgcn_sched_barrier(0);
        if (u + F.G < 1024) { const int un = u + F.G; const size_t rown = (size_t)(un >> 3) * 128; const int chn = (un & 7) * 256 + (tid & 31) * 8;
#pragma unroll
            for (int i = 0; i < 8; ++i) vq[i] = *(const v4u*)(UV + (rown + (tid >> 5) + 16 * i) * 4096 + 2048 + chn);
            const f32x4* p = (const f32x4*)(LNP + ((rown + (tid >> 2)) * 32 + 8 * (tid & 3)) * 2);
#pragma unroll
            for (int i = 0; i < 4; ++i) lp[i] = p[i]; }
        __builtin_amdgcn_sched_barrier(0);
        __syncthreads();
        f32x16 acc[4];
#pragma unroll
        for (int tt = 0; tt < 4; ++tt) acc[tt] = f32x16{};
        lcp vb = (lcp)(lds + wave * 8192 + ((lane >> 4) & 1) * 32 + (lane & 3) * 8 + (4 * hi + ((lane & 15) >> 2)) * 64);
#pragma unroll
        for (int ks = 0; ks < 8; ++ks) {
            const s16x4 a0 = vtr(vb + ks * 1024), a1 = vtr(vb + ks * 1024 + 512);
            const bf16x8 vf = (bf16x8){a0[0], a0[1], a0[2], a0[3], a1[0], a1[1], a1[2], a1[3]};
#pragma unroll
            for (int tt = 0; tt < 4; ++tt) {
                if (ks > 2 * tt + 1) continue;
                const bf16x8 wf = *(const LAS bf16x8*)(WFL + ((tt * (tt + 1) + ks) * 64 + lane) * 16);
                acc[tt] = __builtin_amdgcn_mfma_f32_32x32x16_bf16(vf, wf, acc[tt], 0, 0, 0);
            }
        }
        asm volatile("s_waitcnt lgkmcnt(0)" ::: "memory");
        LAS bf16* sl = (LAS bf16*)(lds + wave * 8192);
#pragma unroll
        for (int tt = 0; tt < 4; ++tt) { const int t = 32 * tt + r32; const float bt = btv[tt];
#pragma unroll
            for (int q4 = 0; q4 < 4; ++q4) {
                typedef unsigned u32x2v __attribute__((ext_vector_type(2)));
                u32x2v w; w.x = cvtpk(acc[tt][4 * q4] + bt, acc[tt][4 * q4 + 1] + bt); w.y = cvtpk(acc[tt][4 * q4 + 2] + bt, acc[tt][4 * q4 + 3] + bt);
                *(LAS u32x2v*)(sl + t * 32 + 8 * q4 + 4 * hi) = w; } }
        asm volatile("s_waitcnt lgkmcnt(0)" ::: "memory");
        const int chn = ch0 + 32 * wave + 8 * (lane & 3);
#pragma unroll
        for (int i = 0; i < 8; ++i) { const int t = 16 * i + (lane >> 2);
            const v4u sv = *(const LAS v4u*)(sl + t * 32 + 8 * (lane & 3));
            const v4u uu = uq[i];
            v4u o;
#pragma unroll
            for (int e = 0; e < 4; ++e) o[e] = pk2(__builtin_bit_cast(float, uu[e] << 16) * __builtin_bit_cast(float, sv[e] << 16), __builtin_bit_cast(float, uu[e] & 0xffff0000u) * __builtin_bit_cast(float, sv[e] & 0xffff0000u));
            *(v4u*)(GT + (row0 + t) * DA + chn) = o; }
    }
}
__device__ __forceinline__ void phase_spatial_sample(const Frame& F, const Args& a, const int l) {
    const int tid = F.tid;
    LAS float* stL = (LAS float*)F.lds;
    const bf16* UV = (const bf16*)(a.ws + WS_UV); const float* LNP = (const float*)(a.ws + WS_LNP); bf16* GT = (bf16*)(a.ws + WS_GATED);
    const float* lng = (const float*)a.in[I_ALNG] + l * DA; const float* lnb = (const float*)a.in[I_ALNB] + l * DA;
    const float* wsp = (const float*)a.in[I_AWS] + (size_t)l * 8 * 128 * 128; const float* bsp = (const float*)a.in[I_ABS] + l * 8 * 128;
    float* av = a.out + O_AV + (size_t)l * 128 * 4 * DA;
    for (int sidx = F.vcu; sidx < 128; sidx += F.G) {
        const size_t row0 = (size_t)MP + 4 * sidx;
        __syncthreads();
        if (tid < 64) { float mean, rstd; ln_row_stats(LNP, row0 + ((tid >> 2) & 3), tid & 3, mean, rstd); if (tid < 16 && (tid & 3) == 0) { stL[2 * (tid >> 2)] = mean; stL[2 * (tid >> 2) + 1] = rstd; } }
        __syncthreads();
        const int c = tid * 4, g = c >> 8;
        const f32x4 gg = *(const f32x4*)(lng + c), bb = *(const f32x4*)(lnb + c);
        f32x4 vl[4];
#pragma unroll
        for (int tt = 0; tt < 4; ++tt) { const float mean = stL[2 * tt], rstd = stL[2 * tt + 1];
            const unsigned long long vv = *(const unsigned long long*)(UV + (row0 + tt) * 4096 + 2048 + c); const unsigned w0 = (unsigned)vv, w1 = (unsigned)(vv >> 32);
            vl[tt].x = (__builtin_bit_cast(float, w0 << 16) - mean) * rstd * gg.x + bb.x; vl[tt].y = (__builtin_bit_cast(float, w0 & 0xffff0000u) - mean) * rstd * gg.y + bb.y;
            vl[tt].z = (__builtin_bit_cast(float, w1 << 16) - mean) * rstd * gg.z + bb.z; vl[tt].w = (__builtin_bit_cast(float, w1 & 0xffff0000u) - mean) * rstd * gg.w + bb.w;
            *(f32x4*)(av + ((size_t)sidx * 4 + tt) * DA + c) = vl[tt]; }
#pragma unroll
        for (int tt = 0; tt < 4; ++tt) { f32x4 sv = (f32x4){0.f, 0.f, 0.f, 0.f};
#pragma unroll
            for (int sx = 0; sx <= tt; ++sx) sv = sv + vl[sx] * wsp[((size_t)g * 128 + tt) * 128 + sx];
            sv = sv + bsp[g * 128 + tt];
            const unsigned long long uu = *(const unsigned long long*)(UV + (row0 + tt) * 4096 + c); const unsigned w0 = (unsigned)uu, w1 = (unsigned)(uu >> 32);
            *(unsigned long long*)(GT + (row0 + tt) * DA + c) = (unsigned long long)pk2(__builtin_bit_cast(float, w0 << 16) * sv.x, __builtin_bit_cast(float, w0 & 0xffff0000u) * sv.y)
                | ((unsigned long long)pk2(__builtin_bit_cast(float, w1 << 16) * sv.z, __builtin_bit_cast(float, w1 & 0xffff0000u) * sv.w) << 32); }
    }
}


template <bool FINAL> __device__ __forceinline__ void skinny_resid(const Frame& F, const bf16* A, const bf16* Bt, const int K, float* Y, bf16* HB, float* SSQ) {
    using namespace fa;
    const int lane = F.lane, wave = F.wave, tid = F.tid, r32 = lane & 31, hi = lane >> 5;
    LAS float* RL = (LAS float*)F.lds;
    LAS char* AL = (LAS char*)F.lds + wave * 13824; LAS char* BL = AL + 4608;
    const int nchunk = K / 64, c_lo = (wave * nchunk) / 8, c_hi = ((wave + 1) * nchunk) / 8;
    const int lrow = lane >> 3, lpc = lane & 7;
    for (int u = F.vcu; u < 256; u += F.G) {
        const int ct = 2 * (u >> 5) + (u & 1), rt = (u >> 1) & 15;
        const bf16* ap = A + (size_t)(MP + 32 * rt + lrow) * K + lpc * 8;
        const bf16* bp = Bt + (size_t)(64 * ct + lrow) * K + lpc * 8;
        f32x16 acc0 = f32x16{}, acc1 = f32x16{};
        v4u ra[4], rb[8], na[4], nb[8];
#define SK_LOAD(RA, RB, C) do { _Pragma("unroll") for (int i = 0; i < 4; ++i) RA[i] = *(const v4u*)(ap + (size_t)(8 * i) * K + (C) * 64); \
                                _Pragma("unroll") for (int i = 0; i < 8; ++i) RB[i] = *(const v4u*)(bp + (size_t)(8 * i) * K + (C) * 64); } while (0)
#define SK_STEP(RA, RB, NA, NB, C) do { if ((C) + 1 < c_hi) SK_LOAD(NA, NB, (C) + 1); \
            __builtin_amdgcn_sched_barrier(0); \
            _Pragma("unroll") for (int i = 0; i < 4; ++i) *(LAS v4u*)(AL + (8 * i + lrow) * 144 + lpc * 16) = RA[i]; \
            _Pragma("unroll") for (int i = 0; i < 8; ++i) *(LAS v4u*)(BL + (8 * i + lrow) * 144 + lpc * 16) = RB[i]; \
            asm volatile("s_waitcnt lgkmcnt(0)" ::: "memory"); \
            _Pragma("unroll") for (int ks = 0; ks < 4; ++ks) { const bf16x8 af = *(const LAS bf16x8*)(AL + r32 * 144 + ks * 32 + hi * 16); \
                const bf16x8 b0 = *(const LAS bf16x8*)(BL + r32 * 144 + ks * 32 + hi * 16), b1 = *(const LAS bf16x8*)(BL + (32 + r32) * 144 + ks * 32 + hi * 16); \
                acc0 = __builtin_amdgcn_mfma_f32_32x32x16_bf16(af, b0, acc0, 0, 0, 0); acc1 = __builtin_amdgcn_mfma_f32_32x32x16_bf16(af, b1, acc1, 0, 0, 0); } \
            asm volatile("s_waitcnt lgkmcnt(0)" ::: "memory"); } while (0)
        __syncthreads();
        SK_LOAD(ra, rb, c_lo);
#pragma unroll 1
        for (int c = c_lo; c < c_hi; c += 2) { SK_STEP(ra, rb, na, nb, c); if (c + 1 < c_hi) SK_STEP(na, nb, ra, rb, c + 1); }
#undef SK_LOAD
#undef SK_STEP
        __syncthreads();
#pragma unroll
        for (int r = 0; r < 16; ++r) { const int row = crow(r, hi); RL[(wave * 32 + row) * 68 + r32] = acc0[r]; RL[(wave * 32 + row) * 68 + 32 + r32] = acc1[r]; }
        __syncthreads();
        {
            const int row = tid >> 4, c4 = (tid & 15) * 4;
            f32x4 sum = *(const LAS f32x4*)(RL + row * 68 + c4);
#pragma unroll
            for (int w = 1; w < 8; ++w) sum = sum + *(const LAS f32x4*)(RL + (w * 32 + row) * 68 + c4);
            const size_t ro = (size_t)(MP + 32 * rt + row) * DM + 64 * ct + c4;
            const unsigned long long hb = *(const unsigned long long*)(HB + ro); const unsigned h0 = (unsigned)hb, h1 = (unsigned)(hb >> 32);
            f32x4 h; h.x = __builtin_bit_cast(float, h0 << 16) + sum.x; h.y = __builtin_bit_cast(float, h0 & 0xffff0000u) + sum.y; h.z = __builtin_bit_cast(float, h1 << 16) + sum.z; h.w = __builtin_bit_cast(float, h1 & 0xffff0000u) + sum.w;
            if (FINAL) *(f32x4*)(Y + ro) = h;
            else {
            *(unsigned long long*)(HB + ro) = (unsigned long long)pk2(h.x, h.y) | ((unsigned long long)pk2(h.z, h.w) << 32);
            float ss = (h.x * h.x + h.y * h.y) + (h.z * h.z + h.w * h.w);
            ss += __shfl_xor(ss, 1); ss += __shfl_xor(ss, 2); ss += __shfl_xor(ss, 4); ss += __shfl_xor(ss, 8);
            if ((tid & 15) == 0) SSQ[(size_t)(MP + 32 * rt + row) * 16 + ct] = ss; }
        }
    }
}


__device__ __forceinline__ void phase_wincopy(const Frame& F, const Args& a, int part, int nparts, int bidx, int nblk) {
    const f32x4* sw = (const f32x4*)a.in[I_SWIN]; f32x4* wo = (f32x4*)(a.out + O_WINS);
    const size_t NW = (size_t)128 * 508 * 128, per = (NW + nparts - 1) / nparts, lo = per * part, hi = (lo + per < NW) ? lo + per : NW;
    const size_t stride = (size_t)nblk * NTHR;
    for (size_t i0 = lo + (size_t)bidx * NTHR + F.tid; i0 < hi; i0 += 8 * stride) {
        f32x4 v[8];
#pragma unroll
        for (int k = 0; k < 8; ++k) { const size_t i = i0 + (size_t)k * stride; if (i < hi) { const size_t s = i / (508 * 128), r = i % (508 * 128); v[k] = __builtin_nontemporal_load(sw + (s * 512 * 128 + 4 * 128 + r)); } }
#pragma unroll
        for (int k = 0; k < 8; ++k) { const size_t i = i0 + (size_t)k * stride; if (i < hi) { const size_t s = i / (508 * 128), r = i % (508 * 128); __builtin_nontemporal_store(v[k], wo + (s * 512 * 128 + r)); } }
    }
}

#ifndef ATT_PROBE
#define ATT_PROBE
#endif
#ifndef ATT_RLO
#define ATT_RLO M
#endif
constexpr int NPH = 22;
#define KP ((KArgs)__builtin_amdgcn_kernarg_segment_ptr())
#define PH_BEGIN { const int id_ = ph++; if (lo <= id_ && id_ < hi) { Frame F; F.lds = lds_; F.wave = wv_; F.vcu = vcu_; F.G = G_; F.lane = pg8::hw_lane(); F.tid = wv_ * 64 + F.lane;
#define PH_END if (id_ + 1 < hi) xcd_barrier(bar); } }
#define FRESH_F(FN) Frame FN; FN.lds = lds_; FN.wave = wv_; FN.vcu = vcu_; FN.G = G_; FN.lane = pg8::hw_lane(); FN.tid = wv_ * 64 + FN.lane;
template <int l> __device__ __forceinline__ void run_layer(const int wv_, const int vcu_, const int G_, LAS unsigned char* lds_, const Args& args, const XcdBarrier& bar, int& ph, const int lo, const int hi) {
    unsigned char* ws = args.ws;
    float* H = args.out + O_Y;
    bf16* HB = (bf16*)(ws + WS_XN);
    float* SSQA = (float*)(ws + WS_SSQA); float* SSQB = (float*)(ws + WS_SSQB);
    if constexpr (l < 2) {
        PH_BEGIN { pg8::Gemm g{HB, (const bf16*)(ws + WS_WIN) + (size_t)l * 4096 * DM, M, 4096, DM, F.wave}; pg8::StaticOrder S; S.init(M, 4096, F.G, (int)blockIdx.x);
            EpiGelu E{KP}; pg8::gemm_phase<EpiGelu, pg8::StaticOrder, true, true>(F.lds, g, S, E);
            { const int nlong = (F.G == 256) ? 32 : 0, nshort = F.G - nlong;
              if ((int)blockIdx.x >= nlong) { FRESH_F(F3) phase_wincopy(F3, args, l, 2, (int)blockIdx.x - nlong, nshort); } } } PH_END
        PH_BEGIN { phase_spatial_fast(F, args, l); __syncthreads(); FRESH_F(F2) phase_spatial_sample(F2, args, l); } PH_END
        PH_BEGIN { const bf16* A = (const bf16*)(ws + WS_GATED); const bf16* Bt = (const bf16*)(ws + WS_WOUTA) + (size_t)l * DM * DA;
            pg8::Gemm g{A, Bt, MP, DM, DA, F.wave}; pg8::StaticOrder S; S.init(MP, DM, F.G, (int)blockIdx.x);
            EpiResidT<false> E{KP, 0}; pg8::gemm_phase<EpiResidT<false>, pg8::StaticOrder, true, true>(F.lds, g, S, E);
            __syncthreads(); FRESH_F(F2) skinny_resid<false>(F2, A, Bt, DA, H, HB, SSQA); } PH_END
    } else {
        PH_BEGIN { constexpr int N = (l == 2) ? NKVQ : NQ3; pg8::Gemm g{HB, (const bf16*)(ws + (l == 2 ? WS_WKVQ : WS_WQ3)), M, N, DM, F.wave}; pg8::StaticOrder S; S.init(M, N, F.G, (int)blockIdx.x);
            EpiHead E{KP, l};
            pg8::gemm_phase<EpiHead, pg8::StaticOrder, true, true>(F.lds, g, S, E); } PH_END
        if constexpr (l == 2) { PH_BEGIN phase_compress_fast(F, args, 0, (F.G == 256) ? 512 : 680, F.vcu, F.G); PH_END }
        PH_BEGIN { const int first = ((int)blockIdx.x >> 3) & 1;
#pragma unroll 1
            for (int it = 0; it < 2; ++it) { FRESH_F(F2) if ((it ^ first) == 0) phase_attn_prompt<0>(F2, args, (bf16*)(ws + WS_O)); else phase_attn_sample(F2, args); __syncthreads(); } } PH_END
        PH_BEGIN { const bf16* A = (const bf16*)(ws + WS_O); const bf16* Bt = (const bf16*)(ws + WS_WOB) + (size_t)(l - 2) * DM * DM;
            pg8::Gemm g{A, Bt, MP, DM, DM, F.wave}; pg8::StaticOrder S; S.init(MP, DM, F.G, (int)blockIdx.x);
            EpiResidT<false> E{KP, 0}; pg8::gemm_phase<EpiResidT<false>, pg8::StaticOrder, true, true>(F.lds, g, S, E);
            __syncthreads(); FRESH_F(F2) skinny_resid<false>(F2, A, Bt, DM, H, HB, SSQA); } PH_END
    }
    PH_BEGIN { pg8::Gemm g{HB, (const bf16*)(ws + WS_WGU) + (size_t)l * 2 * DFF * DM, M, 2 * DFF, DM, F.wave}; pg8::StaticOrder S; S.init(M, 2 * DFF, F.G, (int)blockIdx.x);
        EpiSwiglu E{KP}; pg8::gemm_phase<EpiSwiglu, pg8::StaticOrder, true, true>(F.lds, g, S, E);
        if constexpr (l < 2) { if (F.G == 256 && (int)blockIdx.x >= 172) { __syncthreads(); FRESH_F(F3) phase_compress_fast(F3, args, 512 + 84 * l, 596 + 84 * l, (int)blockIdx.x - 172, 84); } } } PH_END
    PH_BEGIN { const bf16* A = (const bf16*)(ws + WS_ACT); const bf16* Bt = (const bf16*)(ws + WS_WD) + (size_t)l * DM * DFF;
        pg8::Gemm g{A, Bt, MP, DM, DFF, F.wave}; pg8::StaticOrder S; S.init(MP, DM, F.G, (int)blockIdx.x);
        EpiResidT<(l == 3)> E{KP, 1}; pg8::gemm_phase<EpiResidT<(l == 3)>, pg8::StaticOrder, true, true>(F.lds, g, S, E);
        __syncthreads(); FRESH_F(F2) skinny_resid<(l == 3)>(F2, A, Bt, DFF, H, HB, SSQB); } PH_END
}
__global__ void __launch_bounds__(NTHR, 2) yoco_fwd(Args args) {
    extern __shared__ __attribute__((aligned(16))) unsigned char lds[];
    LAS unsigned char* lds_ = (LAS unsigned char*)lds;
    const int wv_ = __builtin_amdgcn_readfirstlane((int)threadIdx.x >> 6), G_ = gridDim.x;
    int vcu_; { const int bx = blockIdx.x; vcu_ = (G_ % 8 == 0) ? (bx % 8) * (G_ / 8) + bx / 8 : bx; }
    volatile LAS unsigned* MISC = (volatile LAS unsigned*)(lds_ + MISC_OFF);
    for (int u = threadIdx.x; u < (LDS_BYTES - RING_BYTES) / 4; u += NTHR) ((LAS unsigned*)(lds_ + RING_BYTES))[u] = 0u;
    __syncthreads();
    const int lo = args.ph_lo, hi = args.ph_hi;
    const bool use_bar = (hi - lo) > 1;
    unsigned* barw = (unsigned*)(args.ws + WS_CTL) + CW_BAR + args.li * XCD_BAR_WORDS;
    XcdBarrier bar; bar.bar = barw; bar.x = 0; bar.st = nullptr; bar.wv = wv_;
    if (use_bar) { bar = xcd_barrier_post(barw, MISC + 8); bar.wv = wv_; }
    int ph = 0;
    PH_BEGIN phase_prologue(F, args); PH_END
    run_layer<0>(wv_, vcu_, G_, lds_, args, bar, ph, lo, hi);
    run_layer<1>(wv_, vcu_, G_, lds_, args, bar, ph, lo, hi);
    run_layer<2>(wv_, vcu_, G_, lds_, args, bar, ph, lo, hi);
    run_layer<3>(wv_, vcu_, G_, lds_, args, bar, ph, lo, hi);
}
#undef PH_BEGIN
#undef PH_END

#ifndef MK_SPLIT
#define MK_SPLIT 0
#endif
extern "C" void kernel_launch(void* const* d_in, const int* in_sizes, int n_in, void* d_out, int out_size, void* d_ws, size_t ws_size, hipStream_t stream) {
    static int grid = 0;
    if (grid == 0) {
        if (n_in != N_IN || (size_t)out_size != O_END || ws_size < WS_END) { fprintf(stderr, "kernel_launch: unexpected shapes (n_in %d out %d ws %zu)\n", n_in, out_size, ws_size); grid = -1; return; }
        int dev = 0, cus = 0, per_cu = 0;
        if (hipGetDevice(&dev) != hipSuccess || hipDeviceGetAttribute(&cus, hipDeviceAttributeMultiprocessorCount, dev) != hipSuccess) { grid = -1; return; }
        if (hipFuncSetAttribute((const void*)yoco_fwd, hipFuncAttributeMaxDynamicSharedMemorySize, LDS_BYTES) != hipSuccess) { fprintf(stderr, "kernel_launch: hipFuncSetAttribute failed\n"); grid = -1; return; }
        if (hipOccupancyMaxActiveBlocksPerMultiprocessor(&per_cu, (const void*)yoco_fwd, NTHR, LDS_BYTES) != hipSuccess || per_cu < 1) { fprintf(stderr, "kernel_launch: occupancy query says %d\n", per_cu); }
        (void)hipGetLastError();
        grid = cus;
    }
    if (grid < 0) return;
    if (hipMemsetAsync((char*)d_ws + WS_CTL, 0, CTL_ZERO_BYTES, stream) != hipSuccess) return;
    Args a{};
    for (int i = 0; i < N_IN; ++i) a.in[i] = d_in[i];
    a.out = (float*)d_out; a.ws = (unsigned char*)d_ws; a.pad = 0;
#if MK_SPLIT
    for (int p = 0; p < NPH; ++p) { a.ph_lo = p; a.ph_hi = p + 1; a.li = 0; hipLaunchKernelGGL(yoco_fwd, dim3(grid), dim3(NTHR), LDS_BYTES, stream, a); }
#else
    a.ph_lo = 0; a.ph_hi = NPH; a.li = 0; hipLaunchKernelGGL(yoco_fwd, dim3(grid), dim3(NTHR), LDS_BYTES, stream, a);
#endif
    const hipError_t le = hipPeekAtLastError();
    if (le != hipSuccess) fprintf(stderr, "kernel_launch: launch failed: %s\n", hipGetErrorName(le));
}
```
